# Optimizing an MI355X kernel written in HIP

```python
import jax, jax.numpy as jnp
from jax import lax
import numpy as np

D_MODEL = 1024
BATCH = 2
SEQ = 16384
DEPTH = 2

EPS = 1e-6
GRID_W = 64
D_MIX = D_MODEL
HEAD_DIM = 64
ATT_HEADS = (D_MIX // 2) // HEAD_DIM
ATT_KV_HEADS = 2
ATT_GROUP = ATT_HEADS // ATT_KV_HEADS
ATT_WIDTH = ATT_HEADS * HEAD_DIM
KV_WIDTH = ATT_KV_HEADS * HEAD_DIM
ATT_SCALE = HEAD_DIM ** -0.5
Q_BLOCK = 128
ROPE_THETA = 10000.0
ROPE_AXIS_DIM = HEAD_DIM // 2
HGRN_WIDTH = D_MIX // 4
HGRN_DK = 64
HGRN_DV = 64
HGRN_HEADS = HGRN_WIDTH // HGRN_DV
HGRN_CHUNK = 16
CONV_WIDTH = D_MIX - ATT_WIDTH - HGRN_WIDTH
CONV_KERNEL = 31
CONV_PAD = (CONV_KERNEL - 1) // 2
D_FF = 4 * D_MODEL
IN_COLS = ATT_WIDTH + 2 * KV_WIDTH + 5 * HGRN_WIDTH + 2 * CONV_WIDTH

kernel_name = "hybrid_parallel_heads_encoder"


def _in_split_points():
    sizes = [ATT_WIDTH, KV_WIDTH, KV_WIDTH, HGRN_WIDTH, HGRN_WIDTH, HGRN_WIDTH,
             HGRN_WIDTH, HGRN_WIDTH, CONV_WIDTH, CONV_WIDTH]
    points, acc = [], 0
    for s in sizes[:-1]:
        acc += s
        points.append(acc)
    return points


def rms_norm(x, g):
    xf = x.astype(jnp.float32)
    y = xf * lax.rsqrt(jnp.mean(xf * xf, axis=-1, keepdims=True) + EPS)
    return (y * g.astype(jnp.float32)).astype(x.dtype)


def layer_norm(x, g, b):
    xf = x.astype(jnp.float32)
    mu = jnp.mean(xf, axis=-1, keepdims=True)
    xc = xf - mu
    y = xc * lax.rsqrt(jnp.mean(xc * xc, axis=-1, keepdims=True) + EPS)
    return (y * g.astype(jnp.float32) + b.astype(jnp.float32)).astype(x.dtype)


def _rope_angles(pos):
    inv_freq = ROPE_THETA ** (-jnp.arange(0, ROPE_AXIS_DIM, 2, dtype=jnp.float32) / ROPE_AXIS_DIM)
    ang = pos.astype(jnp.float32)[:, None] * inv_freq[None, :]
    return jnp.cos(ang), jnp.sin(ang)


def _rotate(x, cos, sin):
    half = x.shape[-1] // 2
    x1, x2 = x[..., :half], x[..., half:]
    c, s = cos[None, :, None, :], sin[None, :, None, :]
    return jnp.concatenate([x1 * c - x2 * s, x1 * s + x2 * c], axis=-1)


def apply_axial_rope(x, row_cs, col_cs):
    xf = x.astype(jnp.float32)
    out = jnp.concatenate([_rotate(xf[..., :ROPE_AXIS_DIM], *row_cs),
                           _rotate(xf[..., ROPE_AXIS_DIM:], *col_cs)], axis=-1)
    return out.astype(x.dtype)


def block_attention(q, k, v):
    B, L, H, D = q.shape
    nb = L // Q_BLOCK
    qb = q.reshape(B, nb, Q_BLOCK, ATT_KV_HEADS, ATT_GROUP, D).transpose(1, 0, 2, 3, 4, 5)

    def one_block(q_blk):
        s = jnp.einsum("bqhgd,bkhd->bhgqk", q_blk, k).astype(jnp.float32) * ATT_SCALE
        p = jax.nn.softmax(s, axis=-1)
        return jnp.einsum("bhgqk,bkhd->bqhgd", p.astype(v.dtype), v)

    o = lax.map(one_block, qb)
    return o.transpose(1, 0, 2, 3, 4, 5).reshape(B, L, H * D)


def chunk_gated_recurrence(q, k, v, log_f):
    B, L, H, K = q.shape
    V = v.shape[-1]
    C = HGRN_CHUNK
    N = L // C

    def to_chunks(a):
        return a.reshape(B, N, C, H, a.shape[-1]).transpose(0, 3, 1, 2, 4)

    q, k, v, log_f = (to_chunks(a) for a in (q, k, v, log_f))
    b = jnp.cumsum(log_f, axis=3)
    causal = jnp.tril(jnp.ones((C, C), dtype=bool))[:, :, None]
    diff = b[:, :, :, :, None, :] - b[:, :, :, None, :, :]
    decay = jnp.where(causal, jnp.exp(jnp.where(causal, diff, 0.0)), 0.0)
    scores = jnp.einsum("bhnik,bhnjk,bhnijk->bhnij", q, k, decay)
    o_intra = jnp.einsum("bhnij,bhnjv->bhniv", scores, v)
    b_last = b[:, :, :, -1:, :]
    u = jnp.einsum("bhnjk,bhnjv->bhnkv", k * jnp.exp(b_last - b), v)
    chunk_decay = jnp.exp(b_last[:, :, :, 0, :])

    def step(S, inp):
        dec, uu = inp
        return dec[..., None] * S + uu, S

    S0 = jnp.zeros((B, H, K, V), q.dtype)
    _, S_prev = lax.scan(step, S0, (jnp.moveaxis(chunk_decay, 2, 0), jnp.moveaxis(u, 2, 0)))
    S_prev = jnp.moveaxis(S_prev, 0, 2)
    o_inter = jnp.einsum("bhnik,bhnkv->bhniv", q * jnp.exp(b), S_prev)
    return (o_intra + o_inter).transpose(0, 2, 3, 1, 4).reshape(B, L, H, V)


def _layer_lower_bounds(lb_param):
    p = jax.nn.softmax(lb_param.astype(jnp.float32), axis=0)
    return jnp.cumsum(p, axis=0) - p[0:1]


def _forget_gate(z, lb):
    zf = z.astype(jnp.float32)
    log_f = jax.nn.log_sigmoid(zf) + jnp.log1p(lb * jnp.exp(-zf))
    k = (1.0 - lb) * jax.nn.sigmoid(-zf)
    return log_f, k


def hgrn2_bidirectional(q_h, i_h, f_fw, f_bw, g_h, lb_fw, lb_bw, norm_g):
    B, L, _ = q_h.shape
    heads = lambda a: a.astype(jnp.float32).reshape(B, L, HGRN_HEADS, -1)
    q, v = heads(q_h), heads(i_h)
    lb_fw = lb_fw.reshape(HGRN_HEADS, HGRN_DK)
    lb_bw = lb_bw.reshape(HGRN_HEADS, HGRN_DK)
    logf_fw, k_fw = _forget_gate(heads(f_fw), lb_fw)
    logf_bw, k_bw = _forget_gate(heads(f_bw), lb_bw)
    flip = lambda a: jnp.flip(a, axis=1)
    o_fw = chunk_gated_recurrence(q, k_fw, v, logf_fw)
    o_bw = flip(chunk_gated_recurrence(flip(q), flip(k_bw), flip(v), flip(logf_bw)))
    o = rms_norm(o_fw + o_bw, norm_g.reshape(HGRN_HEADS, HGRN_DV))
    o = o.reshape(B, L, HGRN_WIDTH) * jax.nn.silu(g_h.astype(jnp.float32))
    return o.astype(q_h.dtype)


def conformer_conv(a, gate, w_dw, b_dw, ln_g, ln_b):
    u = a * jax.nn.sigmoid(gate)
    y = lax.conv_general_dilated(u, w_dw[:, None, :], window_strides=(1,),
                                 padding=[(CONV_PAD, CONV_PAD)],
                                 dimension_numbers=("NWC", "WIO", "NWC"),
                                 feature_group_count=CONV_WIDTH)
    y = layer_norm(y + b_dw, ln_g, ln_b)
    return jax.nn.silu(y)


def setup_inputs(seed: int = 0) -> dict:
    key = jax.random.key(seed)
    ks = jax.random.split(key, 16)
    n = lambda k, shape: jax.random.normal(k, shape, jnp.float32)
    return {
        "x": n(ks[0], (BATCH, SEQ, D_MODEL)),
        "w_in": n(ks[1], (DEPTH, D_MODEL, IN_COLS)) * D_MODEL ** -0.5,
        "w_out": n(ks[2], (DEPTH, D_MIX, D_MODEL)) * D_MIX ** -0.5,
        "norm_mix": 1.0 + 0.05 * n(ks[3], (DEPTH, D_MODEL)),
        "norm_mlp": 1.0 + 0.05 * n(ks[4], (DEPTH, D_MODEL)),
        "q_norm": 1.0 + 0.05 * n(ks[5], (DEPTH, HEAD_DIM)),
        "k_norm": 1.0 + 0.05 * n(ks[6], (DEPTH, HEAD_DIM)),
        "hgrn_lb_fwd": 0.5 * n(ks[7], (DEPTH, HGRN_WIDTH)),
        "hgrn_lb_bwd": 0.5 * n(ks[8], (DEPTH, HGRN_WIDTH)),
        "hgrn_norm": 1.0 + 0.05 * n(ks[9], (DEPTH, HGRN_WIDTH)),
        "conv_w": n(ks[10], (DEPTH, CONV_KERNEL, CONV_WIDTH)) * CONV_KERNEL ** -0.5,
        "conv_b": 0.02 * n(ks[11], (DEPTH, CONV_WIDTH)),
        "conv_ln_g": 1.0 + 0.05 * n(ks[12], (DEPTH, CONV_WIDTH)),
        "conv_ln_b": 0.02 * n(ks[13], (DEPTH, CONV_WIDTH)),
        "w_mlp_in": n(ks[14], (DEPTH, D_MODEL, D_FF)) * D_MODEL ** -0.5,
        "w_mlp_out": n(ks[15], (DEPTH, D_FF, D_MODEL)) * D_FF ** -0.5,
    }


def reference(x, w_in, w_out, norm_mix, norm_mlp, q_norm, k_norm, hgrn_lb_fwd, hgrn_lb_bwd,
              hgrn_norm, conv_w, conv_b, conv_ln_g, conv_ln_b, w_mlp_in, w_mlp_out):
    B, L, _ = x.shape
    rows = L // GRID_W
    row_idx = jnp.broadcast_to(jnp.arange(rows)[:, None], (rows, GRID_W)).reshape(L)
    col_idx = jnp.broadcast_to(jnp.arange(GRID_W)[None, :], (rows, GRID_W)).reshape(L)
    row_cs, col_cs = _rope_angles(row_idx), _rope_angles(col_idx)
    lb_fwd = _layer_lower_bounds(hgrn_lb_fwd)
    lb_bwd = _layer_lower_bounds(hgrn_lb_bwd)
    splits = _in_split_points()

    for l in range(DEPTH):
        h = rms_norm(x, norm_mix[l])
        z = h @ w_in[l]
        (q_a, k_a, v_a, q_h, i_h, f_fw, f_bw, g_h, a_c, g_c) = jnp.split(z, splits, axis=-1)

        q_a = rms_norm(q_a.reshape(B, L, ATT_HEADS, HEAD_DIM), q_norm[l])
        k_a = rms_norm(k_a.reshape(B, L, ATT_KV_HEADS, HEAD_DIM), k_norm[l])
        q_a = apply_axial_rope(q_a, row_cs, col_cs)
        k_a = apply_axial_rope(k_a, row_cs, col_cs)
        v_a = v_a.reshape(B, L, ATT_KV_HEADS, HEAD_DIM)
        o_att = block_attention(q_a, k_a, v_a)

        o_hg = hgrn2_bidirectional(q_h, i_h, f_fw, f_bw, g_h,
                                   lb_fwd[l], lb_bwd[l], hgrn_norm[l])

        o_cv = conformer_conv(a_c, g_c, conv_w[l], conv_b[l],
                              conv_ln_g[l], conv_ln_b[l])

        mix = jnp.concatenate([o_att, o_hg.astype(x.dtype), o_cv], axis=-1)
        x = x + mix @ w_out[l]

        h = rms_norm(x, norm_mlp[l])
        x = x + jnp.square(jax.nn.relu(h @ w_mlp_in[l])) @ w_mlp_out[l]
    return x
```

```cpp
#include <hip/hip_runtime.h>
#include <hip/hip_bf16.h>
#include <hip/hip_cooperative_groups.h>
#include <cstdio>
#include <cstdint>
#include <cmath>
namespace cg = cooperative_groups;

constexpr int TOK = 32768, SEQL = 16384, DMODEL = 1024, INCOLS = 2560, DFF = 4096, ZRP = 1792;
constexpr float EPS = 1e-6f;
constexpr float QSCALE = 0.125f * 1.4426950408889634f;

namespace pg8 {
#define PG8_LAS __attribute__((address_space(3)))
typedef unsigned short bf16_t;
typedef short bf16x8 __attribute__((ext_vector_type(8)));
typedef float f32x4 __attribute__((ext_vector_type(4)));
typedef unsigned u32x4 __attribute__((ext_vector_type(4)));
constexpr int BM = 256, BK = 64, HALF = 128, HTB = HALF * BK * 2  , STAGE_BYTES = 8 * HTB, NXCD = 8, WGM = 8;

__host__ __device__ __forceinline__ int lds_byte(int r, int c) { const int st = (r >> 4) * 2 + (c >> 5), rr = r & 15, cc = c & 31, ob = rr * 64 + cc * 2; return st * 1024 + (ob ^ (((ob >> 9) & 1) << 5)); }
__host__ __device__ __forceinline__ void stage_rc(int b, int& R, int& C) { const int st = b / 1024, sb = b % 1024, swz = sb ^ (((sb >> 9) & 1) << 5); R = (st >> 1) * 16 + swz / 64; C = (st & 1) * 32 + (swz % 64) / 2; }
__host__ __device__ __forceinline__ int perm32(int rho) { const int n = rho >> 4, i = rho & 15; return 8 * (i >> 2) + 4 * n + (i & 3); }

struct Unit { int pm, pn; };
struct Gemm { const bf16_t* A; const bf16_t* Bt; int M, N, K; };

struct StaticOrder {
    int nM, nN, nwg, G, c;
    __host__ __device__ void init(int M, int N, int G_, int c_) { nM = M / BM; nN = N / BM; nwg = nM * nN; G = G_; c = c_; }
    __host__ __device__ bool next(int i, Unit& u) const {
        const long L = (long)i * G + c; if (L >= nwg) return false;
        int wgid = (int)L; { const int q = nwg / NXCD, r = nwg % NXCD, xcd = wgid % NXCD, off = wgid / NXCD; wgid = (xcd < r ? xcd * (q + 1) : r * (q + 1) + (xcd - r) * q) + off; }
        const int nig = WGM * nN, gid = wgid / nig, fm = gid * WGM, gsz = (nM - fm) < WGM ? (nM - fm) : WGM;
        u.pm = fm + ((wgid % nig) % gsz); u.pn = (wgid % nig) / gsz; return true;
    }
    __device__ __forceinline__ void a_ready(const Unit&) const {}
    __device__ __forceinline__ void done(const Unit&) const {}
};
__device__ __forceinline__ unsigned cvt_pk_bf16(float lo, float hi) { unsigned r; asm volatile("v_cvt_pk_bf16_f32 %0, %1, %2" : "=v"(r) : "v"(lo), "v"(hi)); return r; }
typedef float f32x2 __attribute__((ext_vector_type(2)));
typedef unsigned u32x2 __attribute__((ext_vector_type(2)));
__device__ __forceinline__ float rsq(float x) { return __builtin_amdgcn_rsqf(x); }
__device__ __forceinline__ float dot4(f32x4 a) { return (a[0] * a[0] + a[1] * a[1]) + (a[2] * a[2] + a[3] * a[3]); }

struct EpiInProj {
    static constexpr bool PERM = false, AFTER_DRAIN = false;
    const float* ssq; bf16_t* Q; bf16_t* Kb; bf16_t* Vb; bf16_t* ZR; const float* qg; const float* kg; const float* ropec; const float* ropes;
    __device__ __forceinline__ void operator()(const f32x4 (&acc)[2][2][4][2], const Unit& u, int wr, int wc, int fr, int fq) const {
        const int row0 = u.pm * BM + wr * 64 + fr;
        if (u.pn >= 3) {
            const int col0 = (u.pn - 3) * 256 + wc * 32 + 8 * fq;
#pragma unroll
            for (int ai = 0; ai < 2; ++ai)
#pragma unroll
                for (int m = 0; m < 4; ++m) {
                    const int row = row0 + ai * HALF + m * 16;
                    const float rinv = rsq(ssq[row] * (1.f / 1024.f) + EPS);
                    bf16_t* rowp = ZR + (size_t)row * ZRP + col0;
#pragma unroll
                    for (int bj = 0; bj < 2; ++bj) { const f32x4 v0 = acc[ai][bj][m][0] * rinv, v1 = acc[ai][bj][m][1] * rinv;
                        u32x4 w; w.x = cvt_pk_bf16(v0[0], v0[1]); w.y = cvt_pk_bf16(v0[2], v0[3]); w.z = cvt_pk_bf16(v1[0], v1[1]); w.w = cvt_pk_bf16(v1[2], v1[3]);
                        *(u32x4*)(rowp + bj * HALF) = w; }
                }
        } else {
            const int hh = 4 * u.pn + wc;
            const bool isq = hh < 8, isk = (hh >= 8 && hh < 10), nrm = isq || isk;
            bf16_t* dst; int pitch;
            if (isq) { dst = Q + hh * 64; pitch = 512; } else if (isk) { dst = Kb + (hh - 8) * 64; pitch = 128; } else { dst = Vb + (hh - 10) * 64; pitch = 128; }
            const float* gp = isq ? qg : kg;
            f32x4 gv[2][2];
#pragma unroll
            for (int bj = 0; bj < 2; ++bj)
#pragma unroll
                for (int n = 0; n < 2; ++n) gv[bj][n] = *(const f32x4*)(gp + 32 * bj + 16 * n + 4 * fq);
            const float osc = isq ? QSCALE : 1.f;
#pragma unroll
            for (int ai = 0; ai < 2; ++ai)
#pragma unroll
                for (int m = 0; m < 4; ++m) {
                    const int row = row0 + ai * HALF + m * 16;
                    const float rinv = rsq(ssq[row] * (1.f / 1024.f) + EPS);
                    f32x4 v[2][2]; float ss = 0.f;
#pragma unroll
                    for (int bj = 0; bj < 2; ++bj)
#pragma unroll
                        for (int n = 0; n < 2; ++n) { v[bj][n] = acc[ai][bj][m][n] * rinv; ss += dot4(v[bj][n]); }
                    if (nrm) {
                        ss += __shfl_xor(ss, 16); ss += __shfl_xor(ss, 32);
                        const float rn = rsq(ss * (1.f / 64.f) + EPS);
                        const int t = row & (SEQL - 1);
#pragma unroll
                        for (int bj = 0; bj < 2; ++bj) { const int pos = bj ? (t & 63) : (t >> 6);
                            const f32x4 c4 = *(const f32x4*)(ropec + pos * 16 + 4 * fq), s4 = *(const f32x4*)(ropes + pos * 16 + 4 * fq);
                            const f32x4 x1 = v[bj][0] * rn * gv[bj][0], x2 = v[bj][1] * rn * gv[bj][1];
                            v[bj][0] = (x1 * c4 - x2 * s4) * osc; v[bj][1] = (x1 * s4 + x2 * c4) * osc; }
                    }
                    bf16_t* rowp = dst + (size_t)row * pitch + 4 * fq;
#pragma unroll
                    for (int bj = 0; bj < 2; ++bj)
#pragma unroll
                        for (int n = 0; n < 2; ++n) { u32x2 w; w.x = cvt_pk_bf16(v[bj][n][0], v[bj][n][1]); w.y = cvt_pk_bf16(v[bj][n][2], v[bj][n][3]); *(u32x2*)(rowp + 32 * bj + 16 * n) = w; }
                }
        }
    }
};
struct EpiResid {
    static constexpr bool PERM = false, AFTER_DRAIN = false;
    const float* base; float* out; bf16_t* xb; float* ssq;
    __device__ __forceinline__ void operator()(const f32x4 (&acc)[2][2][4][2], const Unit& u, int wr, int wc, int fr, int fq) const {
        const int row0 = u.pm * BM + wr * 64 + fr, col0 = u.pn * BM + wc * 32 + 8 * fq;
#pragma unroll
        for (int ai = 0; ai < 2; ++ai)
#pragma unroll
            for (int m = 0; m < 4; ++m) {
                const int row = row0 + ai * HALF + m * 16; const size_t off = (size_t)row * DMODEL + col0; float s = 0.f;
#pragma unroll
                for (int bj = 0; bj < 2; ++bj) {
                    const f32x4 b0 = *(const f32x4*)(base + off + bj * HALF), b1 = *(const f32x4*)(base + off + bj * HALF + 4);
                    const f32x4 v0 = b0 + acc[ai][bj][m][0], v1 = b1 + acc[ai][bj][m][1];
                    *(f32x4*)(out + off + bj * HALF) = v0; *(f32x4*)(out + off + bj * HALF + 4) = v1;
                    s += dot4(v0) + dot4(v1);
                    if (xb) { u32x4 w; w.x = cvt_pk_bf16(v0[0], v0[1]); w.y = cvt_pk_bf16(v0[2], v0[3]); w.z = cvt_pk_bf16(v1[0], v1[1]); w.w = cvt_pk_bf16(v1[2], v1[3]);
                        *(u32x4*)(xb + off + bj * HALF) = w; }
                }
                if (ssq) { s += __shfl_xor(s, 16); s += __shfl_xor(s, 32); if (fq == 0) atomicAdd(ssq + row, s); }
            }
    }
};
struct EpiMlpIn {
    static constexpr bool PERM = false, AFTER_DRAIN = false;
    const float* ssq; bf16_t* H;
    __device__ __forceinline__ void operator()(const f32x4 (&acc)[2][2][4][2], const Unit& u, int wr, int wc, int fr, int fq) const {
        const int row0 = u.pm * BM + wr * 64 + fr, col0 = u.pn * BM + wc * 32 + 8 * fq;
#pragma unroll
        for (int ai = 0; ai < 2; ++ai)
#pragma unroll
            for (int m = 0; m < 4; ++m) {
                const int row = row0 + ai * HALF + m * 16;
                const float rinv = rsq(ssq[row] * (1.f / 1024.f) + EPS);
                bf16_t* rowp = H + (size_t)row * DFF + col0;
#pragma unroll
                for (int bj = 0; bj < 2; ++bj) { f32x4 v0 = acc[ai][bj][m][0] * rinv, v1 = acc[ai][bj][m][1] * rinv;
#pragma unroll
                    for (int j = 0; j < 4; ++j) { const float a = fmaxf(v0[j], 0.f), b = fmaxf(v1[j], 0.f); v0[j] = a * a; v1[j] = b * b; }
                    u32x4 w; w.x = cvt_pk_bf16(v0[0], v0[1]); w.y = cvt_pk_bf16(v0[2], v0[3]); w.z = cvt_pk_bf16(v1[0], v1[1]); w.w = cvt_pk_bf16(v1[2], v1[3]);
                    *(u32x4*)(rowp + bj * HALF) = w; }
            }
    }
};


template <class Epi, class Sched, bool ALIGN_EPI = false, bool SP2 = false>
__device__ __forceinline__ void gemm_phase(PG8_LAS unsigned char* lds, const Gemm g, const Sched& S, const Epi& E) {
    int tid_ = threadIdx.x; asm volatile("" : "+v"(tid_));
    const int tid = tid_, wid = __builtin_amdgcn_readfirstlane(tid >> 6), lane = tid & 63, wr = wid >> 2, wc = wid & 3, fr = lane & 15, fq = lane >> 4;
    const int K = g.K, nt = K / BK;
    unsigned voffA[2], voffB[2];
#pragma unroll
    for (int i = 0; i < 2; ++i) { int R, C; stage_rc(tid * 16 + i * 8192, R, C); const int Rb = Epi::PERM ? ((R & ~31) + perm32(R & 31)) : R;
        voffA[i] = (unsigned)(R * K + C) * 2u; voffB[i] = (unsigned)(Rb * K + C) * 2u; }
    const size_t kstep = (size_t)(BK * 2);
    const size_t hstep = (size_t)HALF * K * 2;
    const size_t tstep = 2 * hstep;
    const unsigned ldsw = (unsigned)wid * 1024u;
    const int aoff = lds_byte(wr * 64 + fr, fq * 8), boff = lds_byte(wc * 32 + fr, fq * 8);
#define PG8_SA(b, h) (((b) * 2 + (h)) * HTB)
#define PG8_SB(b, h) ((4 + (b) * 2 + (h)) * HTB)
#define PG8_STAGE(bufoff, gbase, voff) do { _Pragma("unroll") for (int _i = 0; _i < 2; ++_i) \
        __builtin_amdgcn_global_load_lds((const unsigned*)((const char*)(gbase) + (voff)[_i]), (PG8_LAS unsigned*)(lds + (bufoff) + ldsw + _i * 8192), 16, 0, 0); } while (0)
#define PG8_LDA(dst, b, h) do { _Pragma("unroll") for (int m = 0; m < 4; ++m) _Pragma("unroll") for (int k = 0; k < 2; ++k) dst[m][k] = *(const PG8_LAS bf16x8*)(lds + PG8_SA(b, h) + aoff + m * 2048 + k * 1024); } while (0)
#define PG8_LDB(dst, b, h) do { _Pragma("unroll") for (int n = 0; n < 2; ++n) _Pragma("unroll") for (int k = 0; k < 2; ++k) dst[n][k] = *(const PG8_LAS bf16x8*)(lds + PG8_SB(b, h) + boff + n * 2048 + k * 1024); } while (0)
#define PG8_MMA(ai, bj, At, Bt) do { __builtin_amdgcn_s_setprio(1); _Pragma("unroll") for (int m = 0; m < 4; ++m) _Pragma("unroll") for (int n = 0; n < 2; ++n) _Pragma("unroll") for (int k = 0; k < 2; ++k) \
        acc[ai][bj][m][n] = __builtin_amdgcn_mfma_f32_16x16x32_bf16(Bt[n][k], At[m][k], acc[ai][bj][m][n], 0, 0, 0); __builtin_amdgcn_s_setprio(0); } while (0)
#define PG8_WAIT_V(n) asm volatile("s_waitcnt vmcnt(" #n ")" ::: "memory")
#define PG8_WAIT_L(n) asm volatile("s_waitcnt lgkmcnt(" #n ")" ::: "memory")
#define PG8_BAR __builtin_amdgcn_s_barrier()
#define PG8_SCHED __builtin_amdgcn_sched_barrier(0)
    Unit cur, nxt; int ui = 0;
    if (!S.next(0, cur)) return;
    f32x4 acc[2][2][4][2];
#pragma unroll
    for (int a = 0; a < 2; ++a)
#pragma unroll
        for (int b = 0; b < 2; ++b)
#pragma unroll
            for (int m = 0; m < 4; ++m)
#pragma unroll
                for (int n = 0; n < 2; ++n) acc[a][b][m][n] = (f32x4){0.f, 0.f, 0.f, 0.f};
    bf16x8 At[4][2], B0[2][2], B1[2][2];
    const char* cA = (const char*)g.A + (size_t)cur.pm * tstep; const char* cB = (const char*)g.Bt + (size_t)cur.pn * tstep;
    S.a_ready(cur);
    if constexpr (SP2) {
        PG8_STAGE(PG8_SB(0, 0), cB, voffB); PG8_STAGE(PG8_SB(0, 1), cB + hstep, voffB); PG8_STAGE(PG8_SA(0, 0), cA, voffA); PG8_STAGE(PG8_SA(0, 1), cA + hstep, voffA);
        if (wr == 1) PG8_BAR;
        PG8_WAIT_V(2); PG8_BAR;
        PG8_STAGE(PG8_SB(1, 0), cB + kstep, voffB); PG8_STAGE(PG8_SA(1, 0), cA + kstep, voffA); PG8_STAGE(PG8_SB(1, 1), cB + hstep + kstep, voffB);
        PG8_WAIT_V(6); PG8_BAR;
    } else {
        PG8_STAGE(PG8_SB(0, 0), cB, voffB); PG8_STAGE(PG8_SA(0, 0), cA, voffA); PG8_STAGE(PG8_SB(0, 1), cB + hstep, voffB); PG8_STAGE(PG8_SA(0, 1), cA + hstep, voffA);
        if (wr == 1) PG8_BAR;
        PG8_WAIT_V(4); PG8_BAR;
        PG8_STAGE(PG8_SB(1, 0), cB + kstep, voffB); PG8_STAGE(PG8_SA(1, 0), cA + kstep, voffA); PG8_STAGE(PG8_SB(1, 1), cB + hstep + kstep, voffB);
        PG8_WAIT_V(6); PG8_BAR;
    }
    for (;;) {
        const bool has_next = S.next(ui + 1, nxt);
        const char* nA = has_next ? (const char*)g.A + (size_t)nxt.pm * tstep : cA; const char* nB = has_next ? (const char*)g.Bt + (size_t)nxt.pn * tstep : cB;
        for (int t = 0; t < nt; t += 2) {
            const bool last = (t == nt - 2);
            const char* a1 = cA + (size_t)(t + 1) * kstep;
            const char* a2 = last ? nA : cA + (size_t)(t + 2) * kstep; const char* b2 = last ? nB : cB + (size_t)(t + 2) * kstep;
            const char* a3 = a2 + kstep; const char* b3 = b2 + kstep;
            if (last && has_next) S.a_ready(nxt);
            if constexpr (SP2) {
            PG8_LDB(B0, 0, 0); PG8_LDB(B1, 0, 1); PG8_SCHED; PG8_LDA(At, 0, 0); PG8_STAGE(PG8_SA(1, 1), a1 + hstep, voffA);
            PG8_WAIT_V(8); PG8_WAIT_L(0); PG8_BAR; PG8_MMA(0, 0, At, B0); PG8_MMA(0, 1, At, B1); PG8_BAR; PG8_SCHED;
            PG8_LDA(At, 0, 1); PG8_STAGE(PG8_SB(0, 0), b2, voffB); PG8_STAGE(PG8_SB(0, 1), b2 + hstep, voffB); PG8_STAGE(PG8_SA(0, 0), a2, voffA);
            PG8_WAIT_V(8); PG8_WAIT_L(0); PG8_BAR; PG8_MMA(1, 0, At, B0); PG8_MMA(1, 1, At, B1); PG8_BAR; PG8_SCHED;
            PG8_LDB(B0, 1, 0); PG8_LDB(B1, 1, 1); PG8_SCHED; PG8_LDA(At, 1, 0); PG8_STAGE(PG8_SA(0, 1), a2 + hstep, voffA);
            PG8_WAIT_V(8); PG8_WAIT_L(0); PG8_BAR; PG8_MMA(0, 0, At, B0); PG8_MMA(0, 1, At, B1); PG8_BAR; PG8_SCHED;
            PG8_LDA(At, 1, 1); PG8_STAGE(PG8_SB(1, 0), b3, voffB); PG8_STAGE(PG8_SB(1, 1), b3 + hstep, voffB); PG8_STAGE(PG8_SA(1, 0), a3, voffA);
            PG8_WAIT_V(8); PG8_WAIT_L(0); PG8_BAR; PG8_MMA(1, 0, At, B0); PG8_MMA(1, 1, At, B1); PG8_BAR; PG8_SCHED;
            } else {
            PG8_LDB(B0, 0, 0); PG8_SCHED; PG8_LDA(At, 0, 0); PG8_STAGE(PG8_SA(1, 1), a1 + hstep, voffA);
            PG8_WAIT_L(8); PG8_BAR; PG8_WAIT_L(0); PG8_MMA(0, 0, At, B0); PG8_BAR; PG8_SCHED;
            PG8_LDB(B1, 0, 1); PG8_STAGE(PG8_SB(0, 0), b2, voffB);
            PG8_BAR; PG8_WAIT_L(0); PG8_MMA(0, 1, At, B1); PG8_BAR;
            PG8_LDA(At, 0, 1); PG8_STAGE(PG8_SA(0, 0), a2, voffA);
            PG8_BAR; PG8_WAIT_L(0); PG8_MMA(1, 0, At, B0); PG8_BAR; PG8_SCHED;
            PG8_STAGE(PG8_SB(0, 1), b2 + hstep, voffB);
            PG8_WAIT_V(6); PG8_BAR; PG8_MMA(1, 1, At, B1); PG8_BAR;
            PG8_LDB(B0, 1, 0); PG8_SCHED; PG8_LDA(At, 1, 0); PG8_STAGE(PG8_SA(0, 1), a2 + hstep, voffA);
            PG8_WAIT_L(8); PG8_BAR; PG8_WAIT_L(0); PG8_MMA(0, 0, At, B0); PG8_BAR; PG8_SCHED;
            PG8_LDB(B1, 1, 1); PG8_STAGE(PG8_SB(1, 0), b3, voffB);
            PG8_BAR; PG8_WAIT_L(0); PG8_MMA(0, 1, At, B1); PG8_BAR;
            PG8_LDA(At, 1, 1); PG8_STAGE(PG8_SA(1, 0), a3, voffA);
            PG8_BAR; PG8_WAIT_L(0); PG8_MMA(1, 0, At, B0); PG8_BAR; PG8_SCHED;
            PG8_STAGE(PG8_SB(1, 1), b3 + hstep, voffB);
            PG8_WAIT_V(6); PG8_BAR; PG8_MMA(1, 1, At, B1); PG8_BAR;
            }
        }
        if constexpr (ALIGN_EPI) { if (wr == 0) PG8_BAR; }
        if constexpr (!Epi::AFTER_DRAIN) { E(acc, cur, wr, wc, fr, fq); S.done(cur); }
        if (!has_next) break;
#pragma unroll
        for (int a = 0; a < 2; ++a)
#pragma unroll
            for (int b = 0; b < 2; ++b)
#pragma unroll
                for (int m = 0; m < 4; ++m)
#pragma unroll
                    for (int n = 0; n < 2; ++n) acc[a][b][m][n] = (f32x4){0.f, 0.f, 0.f, 0.f};
        cur = nxt; cA = nA; cB = nB; ++ui;
        if constexpr (ALIGN_EPI) { if (wr == 1) PG8_BAR; }
    }
    PG8_WAIT_V(0);
    if constexpr (!ALIGN_EPI) { if (wr == 0) PG8_BAR; }
    PG8_BAR;
    if constexpr (Epi::AFTER_DRAIN) { E.fused(acc, cur, wr, wc, fr, fq, lds, wid, lane); S.done(cur); }
#undef PG8_SA
#undef PG8_SB
#undef PG8_STAGE
#undef PG8_LDA
#undef PG8_LDB
#undef PG8_MMA
#undef PG8_WAIT_V
#undef PG8_WAIT_L
#undef PG8_BAR
#undef PG8_SCHED
}
}
#define PG8_SP2 true
#define PG8_ALIGN true
#include <hip/hip_bf16.h>
#include <cmath>
namespace attn_body {
using bf16=__hip_bfloat16;
using bf16x8=__attribute__((ext_vector_type(8)))short;
using s16x4=__attribute__((ext_vector_type(4)))short;
using f32x16=__attribute__((ext_vector_type(16)))float;
using u32x4=__attribute__((ext_vector_type(4)))unsigned;
constexpr int BATCH=2,NHEAD=8,SEQ=16384,D=64,QP=512,KP=128,OP=1024;
constexpr int NW=8,QBLK=32,QB=QBLK*NW,KVBLK=64,NQB=SEQ/QB;
constexpr int ATTN_UNIT_ROWS=QB;
__device__ __forceinline__ int crow(int r,int hi){return (r&3)+8*(r>>2)+4*hi;}
#define SBAR() __builtin_amdgcn_sched_barrier(0)
__device__ __forceinline__ void cmask(f32x16&p0,f32x16&p1,int jb,int qrel,int hi){
  const float NEG=-INFINITY; int kb=64*jb+4*hi;
  #pragma unroll
  for(int r=0;r<16;++r){int kv=kb+(r&3)+8*(r>>2); if(kv>qrel)p0[r]=NEG; if(kv+32>qrel)p1[r]=NEG;}
}

constexpr bool ATTN_NOMAX=true;
constexpr int NSLOT=3, SLOTB=8192;
constexpr int LDS_K=0, LDS_V=NSLOT*SLOTB, LDS_WS=2*NSLOT*SLOTB, LDS_OST=LDS_WS+NW*64*4, LDS_BYTES=LDS_OST+NW*4096;
constexpr float C2=0.125f*1.4426950408889634f;
__device__ __forceinline__ void glds16(const void*gsrc,unsigned lds_dst){unsigned keep;
  asm volatile("s_mov_b32 %0, m0\n\ts_mov_b32 m0, %2\n\ts_nop 0\n\tglobal_load_lds_dwordx4 %1, off\n\ts_mov_b32 m0, %0":"=&s"(keep):"v"(gsrc),"s"(lds_dst):"memory");}
__device__ __forceinline__ float max3f(float a,float b,float c){float r;asm("v_max3_f32 %0, %1, %2, %3":"=v"(r):"v"(a),"v"(b),"v"(c));return r;}
__device__ __forceinline__ float max2f(float a,float b){float r;asm("v_max_f32_e32 %0, %1, %2":"=v"(r):"v"(a),"v"(b));return r;}
__device__ __forceinline__ float fadd_s(float a,float b){float r;asm("v_add_f32_e32 %0, %1, %2":"=v"(r):"v"(a),"v"(b));return r;}
__device__ __forceinline__ float fsub_s(float a,float b){float r;asm("v_sub_f32_e32 %0, %1, %2":"=v"(r):"v"(a),"v"(b));return r;}
typedef float f32x2_t __attribute__((ext_vector_type(2))); typedef __bf16 bf16x2_t __attribute__((ext_vector_type(2)));
__device__ __forceinline__ unsigned cvtpk_s(float lo,float hi){f32x2_t v={lo,hi};bf16x2_t b=__builtin_convertvector(v,bf16x2_t);return __builtin_bit_cast(unsigned,b);}
#define WAIT_BAR(N) asm volatile("s_waitcnt vmcnt(" #N ") lgkmcnt(0)\n\ts_barrier":::"memory")

__device__ __forceinline__ void qkt(f32x16&p0,f32x16&p1,const char*Kslot,const bf16x8*qr,const f32x16&negm,int r32,int hi){
  const char*kb=Kslot+hi*1024+r32*16;
  #pragma unroll
  for(int d0=0;d0<4;++d0){
    const bf16x8 b0=*reinterpret_cast<const bf16x8*>(kb+d0*2048);
    const bf16x8 b1=*reinterpret_cast<const bf16x8*>(kb+d0*2048+512);
    if(d0==0){p0=__builtin_amdgcn_mfma_f32_32x32x16_bf16(b0,qr[0],negm,0,0,0);p1=__builtin_amdgcn_mfma_f32_32x32x16_bf16(b1,qr[0],negm,0,0,0);}
    else{p0=__builtin_amdgcn_mfma_f32_32x32x16_bf16(b0,qr[d0],p0,0,0,0);p1=__builtin_amdgcn_mfma_f32_32x32x16_bf16(b1,qr[d0],p1,0,0,0);}}
}
typedef __attribute__((address_space(3))) const char* lds_cptr;
typedef short v4i16_t __attribute__((ext_vector_type(4)));
__device__ __forceinline__ void kload8(bf16x8*kf,lds_cptr kp){
  kf[0]=*(const __attribute__((address_space(3))) bf16x8*)(kp);      kf[1]=*(const __attribute__((address_space(3))) bf16x8*)(kp+512);
  kf[2]=*(const __attribute__((address_space(3))) bf16x8*)(kp+2048); kf[3]=*(const __attribute__((address_space(3))) bf16x8*)(kp+2560);
  kf[4]=*(const __attribute__((address_space(3))) bf16x8*)(kp+4096); kf[5]=*(const __attribute__((address_space(3))) bf16x8*)(kp+4608);
  kf[6]=*(const __attribute__((address_space(3))) bf16x8*)(kp+6144); kf[7]=*(const __attribute__((address_space(3))) bf16x8*)(kp+6656);
}
__device__ __forceinline__ void kload2(bf16x8*kf,lds_cptr kp,int j){ kf[2*j]=*(const __attribute__((address_space(3))) bf16x8*)(kp+j*2048); kf[2*j+1]=*(const __attribute__((address_space(3))) bf16x8*)(kp+j*2048+512); }
__device__ __forceinline__ s16x4 vtr(lds_cptr p){ return __builtin_bit_cast(s16x4,__builtin_amdgcn_ds_read_tr16_b64_v4i16((__attribute__((address_space(3))) v4i16_t*)p)); }
__device__ __forceinline__ float rowmax(const f32x16&p0,const f32x16&p1){
  float a=max3f(p0[0],p0[1],p1[0]),b=max3f(p0[2],p0[3],p1[1]);a=max3f(a,p1[2],p1[3]);
  #pragma unroll
  for(int r=4;r<16;r+=4){a=max3f(a,p0[r],p0[r+1]);b=max3f(b,p0[r+2],p0[r+3]);a=max3f(a,p1[r],p1[r+1]);b=max3f(b,p1[r+2],p1[r+3]);}
  const float m=max2f(a,b);
  auto rr=__builtin_amdgcn_permlane32_swap(__float_as_uint(m),__float_as_uint(m),false,false);
  return max2f(__uint_as_float(rr[0]),__uint_as_float(rr[1]));
}
__device__ __forceinline__ void pv(f32x16*o,int vb,bf16x8 pa0,bf16x8 pa1,bf16x8 pa2,bf16x8 pa3){
  #pragma unroll
  for(int d0=0;d0<2;++d0){s16x4 lo[4],hi[4];
    #pragma unroll
    for(int ks=0;ks<4;++ks){
      asm volatile("ds_read_b64_tr_b16 %0,%1 offset:%c2":"=&v"(lo[ks]):"v"(vb),"i"(d0*4096+ks*1024):"memory");
      asm volatile("ds_read_b64_tr_b16 %0,%1 offset:%c2":"=&v"(hi[ks]):"v"(vb),"i"(d0*4096+ks*1024+512):"memory");}
    asm volatile("s_waitcnt lgkmcnt(0)":::"memory");SBAR();
    #define PK(k) (bf16x8){lo[k][0],lo[k][1],lo[k][2],lo[k][3],hi[k][0],hi[k][1],hi[k][2],hi[k][3]}
    o[d0]=__builtin_amdgcn_mfma_f32_32x32x16_bf16(pa0,PK(0),o[d0],0,0,0);
    o[d0]=__builtin_amdgcn_mfma_f32_32x32x16_bf16(pa1,PK(1),o[d0],0,0,0);
    o[d0]=__builtin_amdgcn_mfma_f32_32x32x16_bf16(pa2,PK(2),o[d0],0,0,0);
    o[d0]=__builtin_amdgcn_mfma_f32_32x32x16_bf16(pa3,PK(3),o[d0],0,0,0);
    #undef PK
  }
}

#ifndef ATTN_STORE16
#define ATTN_STORE16(p,v) (*(u32x4*)(p)=(v))
#endif
template<int THRL> __device__ __forceinline__ void attn_unit(int b,int h,int qb,const bf16*Q,const bf16*__restrict__ K,const bf16*__restrict__ V,bf16*O,char*shm){
  int tid_=threadIdx.x; asm volatile("":"+v"(tid_)); const int tid=tid_,lane=tid&63,r32=lane&31,hi=lane>>5; const int wid=__builtin_amdgcn_readfirstlane(tid>>6);
  const long rowbase=(long)b*SEQ; const int q0=qb*QB;
  const bf16*Qw=Q+(rowbase+q0+wid*QBLK)*QP+h*D;
  const bf16*Kh=K+rowbase*KP+(h>>2)*D,*Vh=V+rowbase*KP+(h>>2)*D;
  const unsigned lds0=(unsigned)(uintptr_t)shm;
  float*wsf=(float*)(shm+LDS_WS)+wid*64;
  const bf16*ksrc=Kh+(long)lane*KP+wid*8;
  const bf16*vsrc=Vh+(long)(16*(wid&3)+(lane>>2))*KP+(wid>>2)*32+(lane&3)*8;
  const unsigned kdst=lds0+LDS_K+wid*1024, vdst=lds0+LDS_V+wid*1024;
  #define DMA_K(t,slot) glds16(ksrc+(long)(t)*KVBLK*KP,(unsigned)__builtin_amdgcn_readfirstlane(kdst+(slot)))
  #define DMA_V(t,slot) glds16(vsrc+(long)(t)*KVBLK*KP,(unsigned)__builtin_amdgcn_readfirstlane(vdst+(slot)))
  const int vb0=(int)(lds0+LDS_V)+((lane>>4)&1)*32+(lane&3)*8+(4*hi+((lane&15)>>2))*64;
  const char*Kbase=shm+LDS_K; bf16x8 kf[8];
  const lds_cptr shm3=(lds_cptr)shm; const lds_cptr kp0=shm3+LDS_K+hi*1024+r32*16; const lds_cptr vp0=shm3+LDS_V+((lane>>4)&1)*32+(lane&3)*8+(4*hi+((lane&15)>>2))*64;
  constexpr int NT=SEQ/KVBLK;
  DMA_K(0,0);DMA_V(0,0);DMA_K(1,SLOTB);
  bf16x8 qr[4];
  #pragma unroll
  for(int d0=0;d0<4;++d0)qr[d0]=*reinterpret_cast<const bf16x8*>(&Qw[(long)r32*QP+d0*16+hi*8]);
  float mhat=0.f,l_reg=0.f;f32x16 o[2];o[0]=f32x16{};o[1]=f32x16{};f32x16 negm=f32x16{};asm volatile("":"+v"(negm));
  #define CMASK(P0,P1,t) do{}while(0)
  bool resc=false;
  #define START(P0,P1) do{ resc=false; \
    if(!ATTN_NOMAX){ const float rm=rowmax(P0,P1); const float dl=rm; mhat=fadd_s(mhat,dl); \
      _Pragma("unroll") for(int r=0;r<16;++r){P0[r]=fsub_s(P0[r],dl);P1[r]=fsub_s(P1[r],dl);} \
      _Pragma("unroll") for(int r=0;r<16;++r)negm[r]=-mhat; asm volatile("":"+v"(negm)); } \
    _Pragma("unroll") for(int r=0;r<16;++r)P0[r]=__builtin_amdgcn_exp2f(P0[r]); }while(0)
  #define RESC() do{ if(resc){ asm volatile("s_waitcnt lgkmcnt(0)":::"memory"); \
      _Pragma("unroll") for(int d_=0;d_<2;++d_) _Pragma("unroll") for(int r=0;r<16;++r)o[d_][r]*=wsf[crow(r,hi)]; } }while(0)
  f32x16 pA0,pA1,pB0,pB1;
  int sl_prev=0,sl_cur=0,sl_next=SLOTB;
  #define ROT() do{sl_prev=sl_cur;sl_cur=sl_next;sl_next=(sl_next==(NSLOT-1)*SLOTB)?0:sl_next+SLOTB;}while(0)
  DMA_K(2,2*SLOTB);
  WAIT_BAR(3);
  qkt(pA0,pA1,Kbase,qr,negm,r32,hi);asm volatile("s_nop 15\n\ts_nop 7":"+v"(pA0),"+v"(pA1));CMASK(pA0,pA1,0);
  START(pA0,pA1);
  _Pragma("unroll") for(int r=0;r<16;++r)pA1[r]=__builtin_amdgcn_exp2f(pA1[r]);
  WAIT_BAR(0);
  DMA_K(3,0);DMA_V(1,SLOTB);
  ROT();
  kload8(kf,kp0+sl_cur);
  WAIT_BAR(2);
  s16x4 vlo[8],vhi[8]; u32x4 pw0,pw1,pw2,pw3;
  #define PKW(P,B) cvtpk_s(P[B],P[B+1])
  #define PAF(k) __builtin_bit_cast(bf16x8,pw##k)
  #define VFR(i) (bf16x8){vlo[i][0],vlo[i][1],vlo[i][2],vlo[i][3],vhi[i][0],vhi[i][1],vhi[i][2],vhi[i][3]}
  #define PIN(x) asm volatile("":"+v"(x))
  #define MX3(a,b,c) __builtin_fmaxf(__builtin_fmaxf((a),(b)),(c))
  #define GAPA(MF,A0,A1,A2,A3,W0,W1,PW) do{ MF; sacc+=A0; sacc+=A1; sacc+=A2; sacc+=A3; PIN(sacc); W0; W1; PIN(PW); SBAR(); }while(0)
  #define EX(v) __builtin_amdgcn_exp2f(v)
  #define GAPB(MF,X,B) do{ MF; X[B]=EX(X[B]); X[B+1]=EX(X[B+1]); X[B+2]=EX(X[B+2]); X[B+3]=EX(X[B+3]); PIN(X); SBAR(); }while(0)
  #define VRD(i) do{ vlo[i]=vtr(vp_+(((i)>>2)*4096+((i)&3)*1024)); vhi[i]=vtr(vp_+(((i)>>2)*4096+((i)&3)*1024+512)); }while(0)
  #define KRD(G,j) do{ if(G){ kload2(kf,kp0+sl_next,j); SBAR(); } }while(0)
  #define STEP(C0,C1,P0,P1,t,GK,GV,GL) do{ SBAR(); \
    const lds_cptr vp_=vp0+sl_prev; \
    VRD(0); SBAR(); float sacc=(P0[0]+P0[1]); \
    GAPA(C0=__builtin_amdgcn_mfma_f32_32x32x16_bf16(kf[0],qr[0],negm,0,0,0), P0[2],P0[3],P0[4],P0[5],     pw0[0]=PKW(P0,0), pw0[1]=PKW(P0,2), pw0); \
    VRD(4); SBAR(); GAPA(C1=__builtin_amdgcn_mfma_f32_32x32x16_bf16(kf[1],qr[0],negm,0,0,0), P0[6],P0[7],P0[8],P0[9],     pw0[2]=PKW(P0,4), pw0[3]=PKW(P0,6), pw0); \
    VRD(1); SBAR(); GAPA(C0=__builtin_amdgcn_mfma_f32_32x32x16_bf16(kf[2],qr[1],C0,0,0,0),   P0[10],P0[11],P0[12],P0[13], pw1[0]=PKW(P0,8), pw1[1]=PKW(P0,10), pw1); \
    VRD(5); SBAR(); GAPA(C1=__builtin_amdgcn_mfma_f32_32x32x16_bf16(kf[3],qr[1],C1,0,0,0),   P0[14],P0[15],P1[0],P1[1],   pw1[2]=PKW(P0,12),pw1[3]=PKW(P0,14), pw1); \
    VRD(2); SBAR(); GAPA(C0=__builtin_amdgcn_mfma_f32_32x32x16_bf16(kf[4],qr[2],C0,0,0,0),   P1[2],P1[3],P1[4],P1[5],     pw2[0]=PKW(P1,0), pw2[1]=PKW(P1,2), pw2); \
    VRD(6); SBAR(); GAPA(C1=__builtin_amdgcn_mfma_f32_32x32x16_bf16(kf[5],qr[2],C1,0,0,0),   P1[6],P1[7],P1[8],P1[9],     pw2[2]=PKW(P1,4), pw2[3]=PKW(P1,6), pw2); \
    VRD(3); SBAR(); GAPA(C0=__builtin_amdgcn_mfma_f32_32x32x16_bf16(kf[6],qr[3],C0,0,0,0),   P1[10],P1[11],P1[12],P1[13], pw3[0]=PKW(P1,8), pw3[1]=PKW(P1,10), pw3); \
    VRD(7); SBAR(); GAPA(C1=__builtin_amdgcn_mfma_f32_32x32x16_bf16(kf[7],qr[3],C1,0,0,0),   P1[14],P1[15],0.f,0.f,       pw3[2]=PKW(P1,12),pw3[3]=PKW(P1,14), pw3); \
    l_reg+=sacc; \
    if(GK){DMA_K((t)+3,sl_cur);} if(GV){DMA_V((t)+1,sl_next);} \
    CMASK(C0,C1,t); \
    resc=false; \
    if(!ATTN_NOMAX){ float a=MX3(C0[0],C0[1],C1[0]),b=MX3(C0[2],C0[3],C1[1]); a=MX3(a,C1[2],C1[3]); \
      _Pragma("unroll") for(int r=4;r<16;r+=4){a=MX3(a,C0[r],C0[r+1]);b=MX3(b,C0[r+2],C0[r+3]);a=MX3(a,C1[r],C1[r+1]);b=MX3(b,C1[r+2],C1[r+3]);} \
      float rm=__builtin_fmaxf(a,b); { auto rr=__builtin_amdgcn_permlane32_swap(__float_as_uint(rm),__float_as_uint(rm),false,false); rm=__builtin_fmaxf(__uint_as_float(rr[0]),__uint_as_float(rr[1])); } \
      resc=false; \
      if(__builtin_expect(__any(rm>(float)THRL),0)){ const float dl=__builtin_fmaxf(rm,0.f); mhat+=dl; \
        _Pragma("unroll") for(int r=0;r<16;++r){C0[r]-=dl;C1[r]-=dl;} \
        _Pragma("unroll") for(int r=0;r<16;++r)negm[r]=-mhat; asm volatile("":"+v"(negm)); \
        const float f=__builtin_amdgcn_exp2f(-dl); l_reg*=f; if(hi==0)wsf[r32]=f; resc=true; } } \
    SBAR(); \
    GAPB(o[0]=__builtin_amdgcn_mfma_f32_32x32x16_bf16(PAF(0),VFR(0),o[0],0,0,0), C0,0); \
    GAPB(o[1]=__builtin_amdgcn_mfma_f32_32x32x16_bf16(PAF(0),VFR(4),o[1],0,0,0), C0,4); \
    KRD(GL,0); GAPB(o[0]=__builtin_amdgcn_mfma_f32_32x32x16_bf16(PAF(1),VFR(1),o[0],0,0,0), C0,8); \
    KRD(GL,1); GAPB(o[1]=__builtin_amdgcn_mfma_f32_32x32x16_bf16(PAF(1),VFR(5),o[1],0,0,0), C0,12); \
    KRD(GL,2); GAPB(o[0]=__builtin_amdgcn_mfma_f32_32x32x16_bf16(PAF(2),VFR(2),o[0],0,0,0), C1,0); \
    KRD(GL,3); GAPB(o[1]=__builtin_amdgcn_mfma_f32_32x32x16_bf16(PAF(2),VFR(6),o[1],0,0,0), C1,4); \
    GAPB(o[0]=__builtin_amdgcn_mfma_f32_32x32x16_bf16(PAF(3),VFR(3),o[0],0,0,0), C1,8); \
    GAPB(o[1]=__builtin_amdgcn_mfma_f32_32x32x16_bf16(PAF(3),VFR(7),o[1],0,0,0), C1,12); \
    }while(0)
  int t=1;
  #undef CMASK
  #define CMASK(P0,P1,t) do{}while(0)
  for(;t+5<NT;t+=2){
    STEP(pB0,pB1,pA0,pA1,t,true,true,true);     WAIT_BAR(2); RESC(); ROT();
    STEP(pA0,pA1,pB0,pB1,t+1,true,true,true);   WAIT_BAR(2); RESC(); ROT();
  }
  #undef CMASK
  #define CMASK(P0,P1,t) do{}while(0)
  #define ENDW(tt) do{ if((tt)+3<NT){WAIT_BAR(2);} else if((tt)+2<NT){WAIT_BAR(1);} else {WAIT_BAR(0);} }while(0)
  for(;t+1<NT;t+=2){
    STEP(pB0,pB1,pA0,pA1,t,(t+3<NT),(t+1<NT),(t+1<NT));       ENDW(t);   RESC(); ROT();
    STEP(pA0,pA1,pB0,pB1,t+1,(t+4<NT),(t+2<NT),(t+2<NT));     ENDW(t+1); RESC(); ROT();
  }
  STEP(pB0,pB1,pA0,pA1,NT-1,false,false,false); RESC();
  { float sacc=pB0[0]+pB0[1]; _Pragma("unroll") for(int r=2;r<16;++r)sacc+=pB0[r]; _Pragma("unroll") for(int r=0;r<16;++r)sacc+=pB1[r]; l_reg+=sacc;
    pw0=(u32x4){PKW(pB0,0),PKW(pB0,2),PKW(pB0,4),PKW(pB0,6)};pw1=(u32x4){PKW(pB0,8),PKW(pB0,10),PKW(pB0,12),PKW(pB0,14)};pw2=(u32x4){PKW(pB1,0),PKW(pB1,2),PKW(pB1,4),PKW(pB1,6)};pw3=(u32x4){PKW(pB1,8),PKW(pB1,10),PKW(pB1,12),PKW(pB1,14)};
    SBAR(); pv(o,vb0+sl_cur,PAF(0),PAF(1),PAF(2),PAF(3)); }
  #undef PKW
  #undef PAF
  #undef VFR
  #undef PIN
  #undef MX3
  #undef GAPA
  #undef GAPB
  #undef EX
  #undef VRD
  #undef KRD
  #undef STEP
  #undef ENDW
  {auto rr=__builtin_amdgcn_permlane32_swap(__float_as_uint(l_reg),__float_as_uint(l_reg),false,false);l_reg=__uint_as_float(rr[0])+__uint_as_float(rr[1]);}
  if(hi==0)wsf[32+r32]=l_reg;asm volatile("s_waitcnt lgkmcnt(0)":::"memory");
  float rli[16];
  #pragma unroll
  for(int r=0;r<16;++r)rli[r]=__builtin_amdgcn_rcpf(wsf[32+crow(r,hi)]);
  bf16*Ow=O+(rowbase+q0+wid*QBLK)*OP+h*D;
  { bf16*stg=(bf16*)(shm+LDS_OST)+wid*2048;
    #pragma unroll
    for(int r=0;r<16;++r){const int orow=crow(r,hi);
      #pragma unroll
      for(int d0=0;d0<2;++d0)stg[orow*64+d0*32+r32]=__float2bfloat16(o[d0][r]*rli[r]);}
    asm volatile("s_waitcnt lgkmcnt(0)":::"memory");
    #pragma unroll
    for(int i=0;i<4;++i){const int row=i*8+(lane>>3),ch=lane&7; const u32x4 v=*(const u32x4*)(stg+row*64+ch*8); ATTN_STORE16(Ow+(long)row*OP+ch*8,v);} }
  asm volatile("s_waitcnt lgkmcnt(0)\n\ts_barrier":::"memory");
  #undef DMA_K
  #undef DMA_V
  #undef CMASK
  #undef START
  #undef RESC
  #undef ROT
}
constexpr int ATTN_LDS_BYTES=LDS_BYTES;
template<int THRL=8> __device__ __forceinline__ void attn_phase(char*lds,const bf16*Q,const bf16*K,const bf16*V,bf16*O,int vcu,int G){
  for(int idx=vcu; idx<BATCH*NHEAD*NQB; idx+=G){ const int bh=idx/NQB, qb=idx%NQB; attn_unit<THRL>(bh/NHEAD,bh%NHEAD,qb,Q,K,V,O,lds); }
}
#undef SBAR
#undef WAIT_BAR
}

constexpr int NWAVES = 8;
#ifndef REP_G1
#define REP_G1 1
#endif
#ifndef REP_G3
#define REP_G3 1
#endif
#ifndef REP_P0
#define REP_P0 1
#endif
#ifndef REP_PASS
#define REP_PASS 1
#endif
#ifndef REP_FIN
#define REP_FIN 1
#endif
#ifndef REP_HG1
#define REP_HG1 1
#endif
#ifndef REP_HG2
#define REP_HG2 1
#endif
#ifndef REP_HG3
#define REP_HG3 1
#endif
#ifndef REP_CONV
#define REP_CONV 1
#endif
#ifndef REP_ATTN
#define REP_ATTN 1
#endif
#ifndef MK_SPLIT
#define MK_SPLIT 0
#endif
constexpr int NPHASE = 15;
constexpr size_t MiB = 1u << 20;
constexpr int LDS_BYTES_ = 147456;
constexpr size_t WS_SSQ = 0;
constexpr size_t WS_BAR = 1024 * 1024, BAR_ZERO_BYTES = 16384;
constexpr int MISC_OFF = LDS_BYTES_ - 64;
constexpr size_t WS_ROPE = 512 * 1024;
constexpr size_t WS_W = 2 * MiB, WL_STRIDE = 23 * MiB, WO_IN = 0, WO_OUT = 5 * MiB, WO_1 = 7 * MiB, WO_2 = 15 * MiB;
constexpr size_t WS_XB = 48 * MiB;
constexpr size_t WS_R = 112 * MiB;
constexpr size_t WS_Q = WS_R, WS_K = WS_R + 32 * MiB, WS_V = WS_R + 40 * MiB, WS_ZR = WS_R + 48 * MiB, WS_MIX = WS_R + 160 * MiB, WS_HA = WS_R + 224 * MiB;
constexpr size_t WS_HID = WS_R;
constexpr size_t WS_HS = 368 * MiB, WS_OFW = 400 * MiB, WS_HD = 432 * MiB, WS_END = 433 * MiB;
constexpr size_t WS_OBW = WS_XB;
constexpr int RING_BYTES = 131072, LDS_BYTES = 147456;

#define LAS __attribute__((address_space(3)))
typedef unsigned short bf16;
typedef unsigned v4u __attribute__((ext_vector_type(4)));
typedef unsigned v2u __attribute__((ext_vector_type(2)));
typedef float f32x4 __attribute__((ext_vector_type(4)));
typedef float f32x2_ __attribute__((ext_vector_type(2)));
typedef short bf16x8 __attribute__((ext_vector_type(8)));
#define LDS_WAIT() asm volatile("s_waitcnt lgkmcnt(0)" ::: "memory")
__device__ __forceinline__ unsigned f2bf(float f) { unsigned u = __builtin_bit_cast(unsigned, f); return (u + 0x7fffu + ((u >> 16) & 1u)) >> 16; }
__device__ __forceinline__ unsigned pk2(float lo, float hi) { return f2bf(lo) | (f2bf(hi) << 16); }
typedef __bf16 bf16x2_ __attribute__((ext_vector_type(2)));
__device__ __forceinline__ unsigned cvtpk(float lo, float hi) { f32x2_ v = {lo, hi}; bf16x2_ b = __builtin_convertvector(v, bf16x2_); return __builtin_bit_cast(unsigned, b); }
__device__ __forceinline__ float bf2f(unsigned h) { return __uint_as_float(h << 16); }
__device__ __forceinline__ float sigmoidf_(float x) { return __builtin_amdgcn_rcpf(1.f + __builtin_amdgcn_exp2f(fmaxf(x, -60.f) * -1.4426950408889634f)); }
__device__ __forceinline__ float wave_sum(float v) {
#pragma unroll
    for (int o = 1; o < 64; o <<= 1) v += __shfl_xor(v, o);
    return v;
}

#define XB_TMO      128
#define XB_XCNT(j)  (256  + 64 * (j))
#define XB_XSUB(j)  (1280 + 64 * (j))
#define XB_XGEN(j)  (2304 + 64 * (j))
#define XB_TOP      3328
#define XB_TOPGEN   3392
#define XCD_BAR_WORDS 3456
#define XB_SPIN_CAP (1u << 18)

__device__ __forceinline__ unsigned xb_ld(unsigned* p)              { return __hip_atomic_load(p, __ATOMIC_RELAXED, __HIP_MEMORY_SCOPE_AGENT); }
__device__ __forceinline__ unsigned xb_add(unsigned* p, unsigned v) { return __hip_atomic_fetch_add(p, v, __ATOMIC_RELAXED, __HIP_MEMORY_SCOPE_AGENT); }
__device__ __forceinline__ unsigned xb_xcc_id() { return (unsigned)__builtin_amdgcn_s_getreg((3 << 11) | 20) & 0xFu; }
#define XB_SPIN(cond, bar) do { unsigned _sp = 0; while (cond) { __builtin_amdgcn_s_sleep(1); \
    if ((++_sp & 255u) == 0u) { if (xb_ld(&(bar)[XB_TMO])) break; if (_sp > XB_SPIN_CAP) { atomicAdd(&(bar)[XB_TMO], 1u); break; } } } } while (0)

struct XcdBarrier {
    unsigned* bar; unsigned x;
    volatile LAS unsigned* st;
};

__device__ __forceinline__ XcdBarrier xcd_barrier_post(unsigned* bar, volatile LAS unsigned* st) {
    XcdBarrier b; b.bar = bar; b.x = xb_xcc_id(); b.st = st;
    if (threadIdx.x == 0) (void)xb_add(&bar[XB_XCNT(b.x)], 1u);
    return b;
}
__device__ __forceinline__ void xcd_barrier_complete(unsigned* bar, unsigned x, unsigned& nloc, unsigned& nx) {
    const unsigned G = gridDim.x * gridDim.y * gridDim.z;
    unsigned sum, cnt, mine, sp = 0u;
    for (;;) {
        sum = 0u; cnt = 0u; mine = 0u;
#pragma unroll
        for (unsigned j = 0; j < 16; ++j) { const unsigned c = xb_ld(&bar[XB_XCNT(j)]); sum += c; cnt += (c > 0u) ? 1u : 0u; mine = (j == x) ? c : mine; }
        if (sum == G) break;
        __builtin_amdgcn_s_sleep(1);
        if ((++sp & 255u) == 0u) { if (xb_ld(&bar[XB_TMO])) break; if (sp > XB_SPIN_CAP) { atomicAdd(&bar[XB_TMO], 1u); break; } }
    }
    nloc = mine > 0u ? mine : 1u; nx = cnt > 0u ? cnt : 1u;
}

__device__ __forceinline__ void xcd_barrier(const XcdBarrier& b) {
    asm volatile("s_waitcnt vmcnt(0)" ::: "memory");
    __syncthreads();
    if (threadIdx.x == 0) {
        unsigned* bar = b.bar;
        __builtin_amdgcn_s_waitcnt(0);
        unsigned nloc = b.st[0], nx = b.st[1];
        if (nloc == 0u) { xcd_barrier_complete(bar, b.x, nloc, nx); b.st[0] = nloc; b.st[1] = nx; }
        const unsigned old = xb_add(&bar[XB_XSUB(b.x)], 1u);
        const unsigned gen = old / nloc;
        if (old + 1u == (gen + 1u) * nloc) {
            __builtin_amdgcn_fence(__ATOMIC_RELEASE, "agent");
            asm volatile("s_waitcnt vmcnt(0)" ::: "memory");
            const unsigned og = xb_add(&bar[XB_TOP], 1u);
            const unsigned tg = og / nx;
            if (og + 1u == (tg + 1u) * nx) xb_add(&bar[XB_TOPGEN], 1u);
            else XB_SPIN(xb_ld(&bar[XB_TOPGEN]) == tg, bar);
            __builtin_amdgcn_fence(__ATOMIC_ACQUIRE, "agent");
            xb_add(&bar[XB_XGEN(b.x)], 1u);
            asm volatile("s_waitcnt vmcnt(0)" ::: "memory");
        } else {
            XB_SPIN(xb_ld(&bar[XB_XGEN(b.x)]) == gen, bar);
            __builtin_amdgcn_fence(__ATOMIC_ACQUIRE, "agent");
            asm volatile("s_waitcnt vmcnt(0)" ::: "memory");
        }
    }
    __syncthreads();
}

struct Params {
    const float *x, *w_in, *w_out, *norm_mix, *norm_mlp, *q_norm, *k_norm, *lb_fwd, *lb_bwd, *hgrn_norm, *conv_w, *conv_b, *conv_ln_g, *conv_ln_b, *w_mlp_in, *w_mlp_out;
    float* out; unsigned char* ws; int ph_lo, ph_hi;
};
typedef const __attribute__((address_space(4))) Params* KP;
struct Frame { LAS unsigned char* lds; int tid, lane, wave, vcu, G; };
__device__ __forceinline__ Frame mkframe(LAS unsigned char* lds) {
    Frame F; int t = threadIdx.x; asm volatile("" : "+v"(t));
    F.lds = lds; F.tid = t; F.lane = t & 63; F.wave = __builtin_amdgcn_readfirstlane(t >> 6);
    F.G = gridDim.x; { const int bx = blockIdx.x; F.vcu = (F.G % 8 == 0) ? (bx % 8) * (F.G / 8) + bx / 8 : bx; }
    return F;
}

__device__ __forceinline__ int phys_row(int n, int mode) {
    if (mode == 1 && n < 768) { const int w = n & 255, hh = w >> 6, d = w & 63; return (n & ~255) + 128 * (d >> 5) + 32 * hh + (d & 31); }
    const int l = n & 31; return (n & ~31) + 16 * ((l >> 2) & 1) + 4 * (l >> 3) + (l & 3);
}
__device__ __forceinline__ void p0_item(const float* W, const float* g, int K, int N, bf16* WT, int mode, LAS float* scr, int item, int lane) {
    const int nblk = N / 32, kb = item / nblk, nb = item % nblk, k0 = 64 * kb, n0 = 32 * nb;
    float wv[32];
#pragma unroll
    for (int i = 0; i < 32; ++i) { const int kk = 2 * i + (lane >> 5); wv[i] = W[(size_t)(k0 + kk) * N + n0 + (lane & 31)] * (g ? g[k0 + kk] : 1.f); }
#pragma unroll
    for (int i = 0; i < 32; ++i) { const int kk = 2 * i + (lane >> 5); scr[kk * 33 + (lane & 31)] = wv[i]; }
    LDS_WAIT(); asm volatile("" ::: "memory");
    const int c = lane & 7;
#pragma unroll
    for (int j = 0; j < 4; ++j) { const int n = (lane >> 3) + 8 * j; const LAS float* s = scr + (8 * c) * 33 + n;
        v4u o; o.x = pk2(s[0 * 33], s[1 * 33]); o.y = pk2(s[2 * 33], s[3 * 33]); o.z = pk2(s[4 * 33], s[5 * 33]); o.w = pk2(s[6 * 33], s[7 * 33]);
        *(v4u*)(WT + (size_t)phys_row(n0 + n, mode) * K + k0 + 8 * c) = o; }
    LDS_WAIT(); asm volatile("" ::: "memory");
}
constexpr int I_IN = (DMODEL / 64) * (INCOLS / 32), I_OUT = (DMODEL / 64) * (DMODEL / 32), I_1 = (DMODEL / 64) * (DFF / 32), I_2 = (DFF / 64) * (DMODEL / 32), I_L = I_IN + I_OUT + I_1 + I_2;
__device__ __forceinline__ void p0_weights(const Frame& F, KP P, LAS float* scr, int first, int last) {
    const int gw = F.vcu * NWAVES + F.wave, NGW = F.G * NWAVES;
    for (int it = first + gw; it < last; it += NGW) {
        const int l = it / I_L; int r = it % I_L; bf16* wb = (bf16*)(P->ws + WS_W + (size_t)l * WL_STRIDE);
        if (r < I_IN) { p0_item(P->w_in + (size_t)l * DMODEL * INCOLS, P->norm_mix + l * DMODEL, DMODEL, INCOLS, (bf16*)((unsigned char*)wb + WO_IN), 1, scr, r, F.lane); continue; } r -= I_IN;
        if (r < I_OUT) { p0_item(P->w_out + (size_t)l * DMODEL * DMODEL, nullptr, DMODEL, DMODEL, (bf16*)((unsigned char*)wb + WO_OUT), 0, scr, r, F.lane); continue; } r -= I_OUT;
        if (r < I_1) { p0_item(P->w_mlp_in + (size_t)l * DMODEL * DFF, P->norm_mlp + l * DMODEL, DMODEL, DFF, (bf16*)((unsigned char*)wb + WO_1), 0, scr, r, F.lane); continue; } r -= I_1;
        p0_item(P->w_mlp_out + (size_t)l * DFF * DMODEL, nullptr, DFF, DMODEL, (bf16*)((unsigned char*)wb + WO_2), 0, scr, r, F.lane);
    }
}
__device__ __forceinline__ void p0_prologue(const Frame& F, KP P) {
    const int gw = F.vcu * NWAVES + F.wave, NGW = F.G * NWAVES;
    p0_weights(F, P, (LAS float*)(F.lds + F.wave * 16384), 0, I_IN);
    float* ssq = (float*)(P->ws + WS_SSQ); bf16* XB = (bf16*)(P->ws + WS_XB);
    for (int m0 = gw * 4; m0 < TOK; m0 += NGW * 4) {
        f32x4 v[4][4]; float sq[4];
#pragma unroll
        for (int i = 0; i < 4; ++i) { const f32x4* xr = (const f32x4*)(P->x + (size_t)(m0 + i) * DMODEL) + F.lane;
#pragma unroll
            for (int j = 0; j < 4; ++j) v[i][j] = xr[64 * j]; }
#pragma unroll
        for (int i = 0; i < 4; ++i) { float s = 0.f;
#pragma unroll
            for (int j = 0; j < 4; ++j) s += (v[i][j].x * v[i][j].x + v[i][j].y * v[i][j].y) + (v[i][j].z * v[i][j].z + v[i][j].w * v[i][j].w);
            sq[i] = wave_sum(s);
            v2u* o8 = (v2u*)(XB + (size_t)(m0 + i) * DMODEL) + F.lane;
#pragma unroll
            for (int j = 0; j < 4; ++j) { v2u w; w.x = cvtpk(v[i][j].x, v[i][j].y); w.y = cvtpk(v[i][j].z, v[i][j].w); o8[64 * j] = w; } }
        if (F.lane < 4) ssq[m0 + F.lane] = F.lane == 0 ? sq[0] : F.lane == 1 ? sq[1] : F.lane == 2 ? sq[2] : sq[3];
    }
    const int gt = F.vcu * (NWAVES * 64) + F.tid, NGT = F.G * NWAVES * 64;
    for (int i = gt; i < 3 * TOK; i += NGT) ssq[TOK + i] = 0.f;
    float* rc = (float*)(P->ws + WS_ROPE); float* rs = rc + 256 * 16;
    for (int i = gt; i < 256 * 16; i += NGT) { const int pos = i >> 4, k = i & 15;
        const float invf = (float)pow(10000.0, -(double)k / 16.0); const float ang = (float)pos * invf;
        rc[i] = (float)cos((double)ang); rs[i] = (float)sin((double)ang); }
}

constexpr int HG_QB = 0, HG_KB = 4352, HG_KBT = 8704, HG_VT = 12800, HG_DEC = 16896, HG_WAVE_BYTES = 17152;
template <bool FULL>
__device__ __forceinline__ float hg_prep(LAS unsigned char* w, const bf16* zbase, int tok0, int step, int dir, float lb, int lane) {
    float E = 1.f; unsigned kbt[16], vtp[16]; const float oml = 1.f - lb;
#pragma unroll
    for (int tp = 0; tp < 16; ++tp) {
        float kb[2], qe[2]; unsigned vr[2];
#pragma unroll
        for (int u = 0; u < 2; ++u) {
            const bf16* zr = zbase + (size_t)(tok0 + step * (2 * tp + u)) * ZRP + lane;
            const float zf = fmaxf(bf2f(zr[512 + 256 * dir]), -60.f); vr[u] = zr[256];
            const float e = __builtin_amdgcn_exp2f(zf * -1.4426950408889634f), s = __builtin_amdgcn_rcpf(1.f + e);
            const float f = lb + oml * s, kk = oml * e * s;
            E *= f;
            kb[u] = kk * __builtin_amdgcn_rcpf(fmaxf(E, 1e-30f));
            if (FULL) qe[u] = bf2f(zr[0]) * E;
        }
        kbt[tp] = cvtpk(kb[0], kb[1]); vtp[tp] = vr[0] | (vr[1] << 16);
        if (FULL) { const unsigned qp = cvtpk(qe[0], qe[1]);
            ((LAS bf16*)(w + HG_QB))[(2 * tp) * 68 + lane] = (bf16)qp; ((LAS bf16*)(w + HG_QB))[(2 * tp + 1) * 68 + lane] = (bf16)(qp >> 16);
            ((LAS bf16*)(w + HG_KB))[(2 * tp) * 68 + lane] = (bf16)kbt[tp]; ((LAS bf16*)(w + HG_KB))[(2 * tp + 1) * 68 + lane] = (bf16)(kbt[tp] >> 16); }
        if ((tp & 7) == 7) asm volatile("" ::: "memory");
    }
#pragma unroll
    for (int i = 0; i < 4; ++i) {
        *(LAS v4u*)(w + HG_KBT + lane * 64 + 16 * i) = (v4u){kbt[4 * i], kbt[4 * i + 1], kbt[4 * i + 2], kbt[4 * i + 3]};
        *(LAS v4u*)(w + HG_VT + lane * 64 + 16 * i) = (v4u){vtp[4 * i], vtp[4 * i + 1], vtp[4 * i + 2], vtp[4 * i + 3]}; }
    ((LAS float*)(w + HG_DEC))[lane] = E;
    return E;
}
__device__ __forceinline__ void hg_update(f32x4 (&S)[4][4], LAS unsigned char* w, int r, int q) {
    bf16x8 a[4], bv[4];
#pragma unroll
    for (int t = 0; t < 4; ++t) { a[t] = *(const LAS bf16x8*)(w + HG_KBT + (16 * t + r) * 64 + 16 * q); bv[t] = *(const LAS bf16x8*)(w + HG_VT + (16 * t + r) * 64 + 16 * q); }
#pragma unroll
    for (int kt = 0; kt < 4; ++kt) { const f32x4 d = *(const LAS f32x4*)(w + HG_DEC + (16 * kt + 4 * q) * 4);
#pragma unroll
        for (int vt = 0; vt < 4; ++vt) { S[kt][vt] = __builtin_amdgcn_mfma_f32_16x16x32_bf16(a[kt], bv[vt], S[kt][vt], 0, 0, 0); S[kt][vt] *= d; } }
}
__device__ __forceinline__ float hg_lb(const float* lbp, int layer, int ch) { return layer == 0 ? 0.f : sigmoidf_(lbp[256 + ch] - lbp[ch]); }

__device__ __forceinline__ void hg_local(const Frame& F, KP P, int layer) {
    LAS unsigned char* w = F.lds + F.wave * HG_WAVE_BYTES; const int lane = F.lane, r = lane & 15, q = lane >> 4, dir = F.wave & 1;
    const bf16* ZR = (const bf16*)(P->ws + WS_ZR); float* HA = (float*)(P->ws + WS_HA); float* HD = (float*)(P->ws + WS_HD);
    for (int it = F.vcu * 4 + (F.wave >> 1); it < 1024; it += F.G * 4) {
        const int bh = it >> 7, blk = it & 127, b = bh >> 2, h = bh & 3;
        const bf16* zbase = ZR + (size_t)b * SEQL * ZRP + 64 * h;
        const float lb = hg_lb(dir ? P->lb_bwd : P->lb_fwd, layer, 64 * h + lane);
        f32x4 S[4][4];
#pragma unroll
        for (int a = 0; a < 4; ++a)
#pragma unroll
            for (int c = 0; c < 4; ++c) S[a][c] = (f32x4){0.f, 0.f, 0.f, 0.f};
        float etot = 1.f;
#pragma unroll 1
        for (int cn = 0; cn < 4; ++cn) {
            const int tok0 = dir ? blk * 128 + 127 - 32 * cn : blk * 128 + 32 * cn;
            etot *= hg_prep<false>(w, zbase, tok0, dir ? -1 : 1, dir, lb, lane);
            LDS_WAIT(); __builtin_amdgcn_wave_barrier();
            hg_update(S, w, r, q);
            LDS_WAIT(); __builtin_amdgcn_wave_barrier();
        }
        float* ha = HA + (size_t)(it * 2 + dir) * 4096;
#pragma unroll
        for (int kt = 0; kt < 4; ++kt)
#pragma unroll
            for (int vt = 0; vt < 4; ++vt)
#pragma unroll
                for (int e = 0; e < 4; ++e) ha[(16 * kt + 4 * q + e) * 64 + 16 * vt + r] = S[kt][vt][e];
        HD[(it * 2 + dir) * 64 + lane] = etot;
    }
}
__device__ __forceinline__ void hg_scan(const Frame& F, KP P) {
    if (F.tid >= 256) return;
    const float* HA = (const float*)(P->ws + WS_HA); const float* HD = (const float*)(P->ws + WS_HD); float* HS = (float*)(P->ws + WS_HS);
    for (int idx = F.vcu * 256 + F.tid; idx < 16 * 4096; idx += F.G * 256) {
        const int bh = idx >> 13, dir = (idx >> 12) & 1, e = idx & 4095, k = e >> 6;
        float S = 0.f;
#pragma unroll 1
        for (int s0 = 0; s0 < 128; s0 += 32) {
            float a[32], d[32];
#pragma unroll
            for (int j = 0; j < 32; ++j) { const int blk = dir ? 127 - (s0 + j) : s0 + j; const size_t it2 = (size_t)((bh * 128 + blk) * 2 + dir); a[j] = HA[it2 * 4096 + e]; d[j] = HD[it2 * 64 + k]; }
#pragma unroll
            for (int j = 0; j < 32; ++j) { const int blk = dir ? 127 - (s0 + j) : s0 + j; const size_t it2 = (size_t)((bh * 128 + blk) * 2 + dir); HS[it2 * 4096 + e] = S; S = d[j] * S + a[j]; }
        }
    }
}
__device__ __forceinline__ void hg_out(const Frame& F, KP P, int layer) {
    LAS unsigned char* w = F.lds + F.wave * HG_WAVE_BYTES; const int lane0 = F.lane, dir = F.wave & 1;
    const bf16* ZR = (const bf16*)(P->ws + WS_ZR); const float* HS = (const float*)(P->ws + WS_HS); bf16* MIX = (bf16*)(P->ws + WS_MIX);
    bf16* OFW = (bf16*)(P->ws + WS_OFW); bf16* OBW = (bf16*)(P->ws + WS_OBW); bf16* OD = dir ? OBW : OFW;
    for (int base = F.vcu * 4; base < 1024; base += F.G * 4) {
        const int it = base + (F.wave >> 1);
        const int bh = it >> 7, blk = it & 127, b = bh >> 2, h = bh & 3;
        const bf16* zbase = ZR + (size_t)b * SEQL * ZRP + 64 * h;
#pragma unroll 1
        for (int rp_ = 0; rp_ < REP_PASS; ++rp_) {
            int lane = lane0; asm volatile("" : "+v"(lane)); const int r = lane & 15, q = lane >> 4;
            const float lb = hg_lb(dir ? P->lb_bwd : P->lb_fwd, layer, 64 * h + lane);
            f32x4 S[4][4];
            { const float* hs = HS + (size_t)(it * 2 + dir) * 4096;
#pragma unroll
              for (int kt = 0; kt < 4; ++kt)
#pragma unroll
                for (int vt = 0; vt < 4; ++vt)
#pragma unroll
                    for (int e = 0; e < 4; ++e) S[kt][vt][e] = hs[(16 * kt + 4 * q + e) * 64 + 16 * vt + r]; }
#pragma unroll 1
            for (int cn = 0; cn < 4; ++cn) {
                const int step = dir ? -1 : 1, tok0 = dir ? blk * 128 + 127 - 32 * cn : blk * 128 + 32 * cn;
                (void)hg_prep<true>(w, zbase, tok0, step, dir, lb, lane);
                LDS_WAIT(); __builtin_amdgcn_wave_barrier();
                bf16x8 qf[2][2], kf[2][2];
#pragma unroll
                for (int t = 0; t < 2; ++t)
#pragma unroll
                    for (int ks = 0; ks < 2; ++ks) {
                        const v2u q0 = *(const LAS v2u*)(w + HG_QB + (16 * t + r) * 136 + 64 * ks + 8 * q), q1 = *(const LAS v2u*)(w + HG_QB + (16 * t + r) * 136 + 64 * ks + 8 * q + 32);
                        const v2u k0 = *(const LAS v2u*)(w + HG_KB + (16 * t + r) * 136 + 64 * ks + 8 * q), k1 = *(const LAS v2u*)(w + HG_KB + (16 * t + r) * 136 + 64 * ks + 8 * q + 32);
                        qf[t][ks] = __builtin_bit_cast(bf16x8, (v4u){q0.x, q0.y, q1.x, q1.y}); kf[t][ks] = __builtin_bit_cast(bf16x8, (v4u){k0.x, k0.y, k1.x, k1.y}); }
                const f32x4 z4 = (f32x4){0.f, 0.f, 0.f, 0.f};
                f32x4 p00 = z4, p01 = z4, p11 = z4;
#pragma unroll
                for (int ks = 0; ks < 2; ++ks) { p00 = __builtin_amdgcn_mfma_f32_16x16x32_bf16(kf[0][ks], qf[0][ks], p00, 0, 0, 0);
                    p01 = __builtin_amdgcn_mfma_f32_16x16x32_bf16(kf[0][ks], qf[1][ks], p01, 0, 0, 0); p11 = __builtin_amdgcn_mfma_f32_16x16x32_bf16(kf[1][ks], qf[1][ks], p11, 0, 0, 0); }
#pragma unroll
                for (int e = 0; e < 4; ++e) { if (4 * q + e > r) { p00[e] = 0.f; p11[e] = 0.f; } }
                bf16x8 pa[2];
                pa[0] = __builtin_bit_cast(bf16x8, (v4u){cvtpk(p00[0], p00[1]), cvtpk(p00[2], p00[3]), 0u, 0u});
                pa[1] = __builtin_bit_cast(bf16x8, (v4u){cvtpk(p01[0], p01[1]), cvtpk(p01[2], p01[3]), cvtpk(p11[0], p11[1]), cvtpk(p11[2], p11[3])});
                f32x4 o[2][4];
#pragma unroll
                for (int vt = 0; vt < 4; ++vt) {
                    const v2u v0 = *(const LAS v2u*)(w + HG_VT + (16 * vt + r) * 64 + 8 * q), v1 = *(const LAS v2u*)(w + HG_VT + (16 * vt + r) * 64 + 8 * q + 32);
                    const bf16x8 vf = __builtin_bit_cast(bf16x8, (v4u){v0.x, v0.y, v1.x, v1.y});
#pragma unroll
                    for (int t = 0; t < 2; ++t) o[t][vt] = __builtin_amdgcn_mfma_f32_16x16x32_bf16(pa[t], vf, z4, 0, 0, 0);
#pragma unroll
                    for (int ks = 0; ks < 2; ++ks) {
                        const f32x4 s0 = S[2 * ks][vt], s1 = S[2 * ks + 1][vt];
                        const bf16x8 sb = __builtin_bit_cast(bf16x8, (v4u){cvtpk(s0[0], s0[1]), cvtpk(s0[2], s0[3]), cvtpk(s1[0], s1[1]), cvtpk(s1[2], s1[3])});
#pragma unroll
                        for (int t = 0; t < 2; ++t) o[t][vt] = __builtin_amdgcn_mfma_f32_16x16x32_bf16(qf[t][ks], sb, o[t][vt], 0, 0, 0);
                    }
                }
                hg_update(S, w, r, q);
#pragma unroll
                for (int t = 0; t < 2; ++t)
#pragma unroll
                    for (int e = 0; e < 4; ++e)
#pragma unroll
                        for (int vt = 0; vt < 4; ++vt) ((LAS bf16*)(w + HG_QB))[(16 * t + 4 * q + e) * 68 + 16 * vt + r] = (bf16)cvtpk(o[t][vt][e], 0.f);
                LDS_WAIT(); __builtin_amdgcn_wave_barrier();
#pragma unroll
                for (int k = 0; k < 4; ++k) {
                    const int ci = k * 64 + lane, row = ci >> 3, c16 = ci & 7;
                    const v2u lo = *(const LAS v2u*)(w + HG_QB + row * 136 + c16 * 16), hi = *(const LAS v2u*)(w + HG_QB + row * 136 + c16 * 16 + 8);
                    *(v4u*)(OD + ((size_t)b * SEQL + (tok0 + step * row)) * 256 + 64 * h + c16 * 8) = (v4u){lo.x, lo.y, hi.x, hi.y};
                }
                LDS_WAIT(); __builtin_amdgcn_wave_barrier();
            }
        }
        asm volatile("s_waitcnt vmcnt(0)" ::: "memory");
        __syncthreads();
#pragma unroll 1
        for (int rf_ = 0; rf_ < REP_FIN; ++rf_) {
            const int tl = lane0 >> 3, vc = (lane0 & 7) * 8;
            const f32x4 g0 = *(const f32x4*)(P->hgrn_norm + layer * 256 + 64 * h + vc), g1 = *(const f32x4*)(P->hgrn_norm + layer * 256 + 64 * h + vc + 4);
            const size_t row0 = (size_t)b * SEQL + blk * 128 + 64 * dir + tl;
            v4u of[8], ob[8], gz[8];
#pragma unroll
            for (int j = 0; j < 8; ++j) { const size_t row = row0 + 8 * j;
                of[j] = *(const v4u*)(OFW + row * 256 + 64 * h + vc); ob[j] = *(const v4u*)(OBW + row * 256 + 64 * h + vc);
                gz[j] = *(const v4u*)(ZR + row * ZRP + 1024 + 64 * h + vc); }
#pragma unroll
            for (int j = 0; j < 8; ++j) { const size_t row = row0 + 8 * j;
                float t[8]; float ss = 0.f;
#pragma unroll
                for (int i = 0; i < 4; ++i) { t[2 * i] = bf2f(of[j][i] & 0xffffu) + bf2f(ob[j][i] & 0xffffu); t[2 * i + 1] = bf2f(of[j][i] >> 16) + bf2f(ob[j][i] >> 16); ss += t[2 * i] * t[2 * i] + t[2 * i + 1] * t[2 * i + 1]; }
                ss += __shfl_xor(ss, 1); ss += __shfl_xor(ss, 2); ss += __shfl_xor(ss, 4);
                const float rn = rsqrtf(ss * (1.f / 64.f) + EPS);
                unsigned ow[4];
#pragma unroll
                for (int i = 0; i < 4; ++i) { const float ga = bf2f(gz[j][i] & 0xffffu), gb = bf2f(gz[j][i] >> 16);
                    const float na = (2 * i < 4) ? g0[2 * i] : g1[2 * i - 4], nb = (2 * i + 1 < 4) ? g0[2 * i + 1] : g1[2 * i + 1 - 4];
                    ow[i] = cvtpk(t[2 * i] * rn * na * (ga * sigmoidf_(ga)), t[2 * i + 1] * rn * nb * (gb * sigmoidf_(gb))); }
                *(v4u*)(MIX + row * 1024 + 512 + 64 * h + vc) = (v4u){ow[0], ow[1], ow[2], ow[3]}; }
        }
        __syncthreads();
    }
}

__device__ __forceinline__ void conv_load(unsigned (&av)[16], unsigned (&gv)[16], const bf16* ZR, int item, int tid) {
    const int b = item >> 9, t0 = (item & 511) * 32, c2 = (tid & 127) * 2, r0 = tid >> 7;
#pragma unroll
    for (int k = 0; k < 16; ++k) { int t = t0 - 15 + r0 + 4 * k; t = t < 0 ? 0 : (t > SEQL - 1 ? SEQL - 1 : t);
        const bf16* zr = ZR + ((size_t)b * SEQL + t) * ZRP; av[k] = *(const unsigned*)(zr + 1280 + c2); gv[k] = *(const unsigned*)(zr + 1536 + c2); }
}
__device__ __forceinline__ void conv_phase(const Frame& F, KP P, int layer) {
    LAS float* U = (LAS float*)F.lds;
    LAS float* Y = U + 62 * 256;
    const bf16* ZR = (const bf16*)(P->ws + WS_ZR); bf16* MIX = (bf16*)(P->ws + WS_MIX);
    const float* cw = P->conv_w + layer * 31 * 256;
    const int c = F.tid & 255, half = F.tid >> 8;
    float wgt[31];
#pragma unroll
    for (int j = 0; j < 31; ++j) wgt[j] = cw[j * 256 + c];
    const float bias = P->conv_b[layer * 256 + c];
    const f32x4 g4 = *(const f32x4*)(P->conv_ln_g + layer * 256 + 4 * F.lane), b4 = *(const f32x4*)(P->conv_ln_b + layer * 256 + 4 * F.lane);
    unsigned av[16], gv[16];
    conv_load(av, gv, ZR, F.vcu < 1024 ? F.vcu : 1023, F.tid);
    for (int item = F.vcu; item < 1024; item += F.G) {
        const int b = item >> 9, t0 = (item & 511) * 32;
        {   const int c2 = (F.tid & 127) * 2, r0 = F.tid >> 7;
#pragma unroll
            for (int k = 0; k < 16; ++k) { const int rr = r0 + 4 * k;
                const int t = t0 - 15 + rr; const bool ok = (t >= 0 && t < SEQL);
                float u0 = bf2f(av[k] & 0xffffu) * sigmoidf_(bf2f(gv[k] & 0xffffu)), u1 = bf2f(av[k] >> 16) * sigmoidf_(bf2f(gv[k] >> 16)); u0 = ok ? u0 : 0.f; u1 = ok ? u1 : 0.f;
                if (rr < 62) *(LAS f32x2_*)(U + rr * 256 + c2) = (f32x2_){u0, u1}; }
        }
        __syncthreads();
        conv_load(av, gv, ZR, item + F.G < 1024 ? item + F.G : 1023, F.tid);
        {
            const LAS float* up = U + (half * 16) * 256 + c; float acc[16];
#pragma unroll
            for (int t = 0; t < 16; ++t) acc[t] = bias;
#pragma unroll
            for (int i = 0; i < 46; ++i) { const float uv = up[i * 256];
#pragma unroll
                for (int t = 0; t < 16; ++t) { if (i - t >= 0 && i - t < 31) acc[t] += wgt[i - t] * uv; } }
#pragma unroll
            for (int t = 0; t < 16; ++t) Y[(half * 16 + t) * 256 + c] = acc[t];
        }
        __syncthreads();
#pragma unroll
        for (int tt = 0; tt < 4; ++tt) { const int tk = F.wave * 4 + tt;
            const f32x4 y = *(const LAS f32x4*)(Y + tk * 256 + 4 * F.lane);
            const float mean = wave_sum((y[0] + y[1]) + (y[2] + y[3])) * (1.f / 256.f);
            const f32x4 d = y - mean; const float var = wave_sum(pg8::dot4(d)) * (1.f / 256.f);
            f32x4 o = d * rsqrtf(var + EPS) * g4 + b4;
#pragma unroll
            for (int j = 0; j < 4; ++j) o[j] = o[j] * sigmoidf_(o[j]);
            v2u wv; wv.x = cvtpk(o[0], o[1]); wv.y = cvtpk(o[2], o[3]);
            *(v2u*)(MIX + ((size_t)b * SEQL + t0 + tk) * 1024 + 768 + 4 * F.lane) = wv; }
        __syncthreads();
    }
}

__global__ void __launch_bounds__(NWAVES * 64, 2) fwd_kernel(Params Pk) {
    extern __shared__ __attribute__((aligned(16))) unsigned char lds[];
    cg::grid_group grid = cg::this_grid();
    const int lo = Pk.ph_lo, hi = Pk.ph_hi;
    if (threadIdx.x < 16) ((LAS unsigned*)((LAS unsigned char*)lds + MISC_OFF))[threadIdx.x] = 0u;
    __syncthreads();
    XcdBarrier xbar; xbar.bar = (unsigned*)(Pk.ws + WS_BAR); xbar.x = 0; xbar.st = nullptr;
    if (hi - lo > 1) xbar = xcd_barrier_post((unsigned*)(Pk.ws + WS_BAR), (volatile LAS unsigned*)((LAS unsigned char*)lds + MISC_OFF));
#define IN(k) (lo <= (k) && (k) < hi)
#define SEAM(k) do { if (IN(k) && IN((k) + 1)) xcd_barrier(xbar); } while (0)
    if (lo < 0) grid.sync();
#define FRESH() const Frame F = mkframe((LAS unsigned char*)lds); KP P = (KP)__builtin_amdgcn_kernarg_segment_ptr(); asm volatile("" : "+s"(P)); unsigned char* const ws = P->ws; (void)ws; (void)F

#ifndef NO_P0
    if (IN(0)) for (int rep_ = 0; rep_ < REP_P0; ++rep_) { FRESH(); p0_prologue(F, P); __syncthreads(); }
#endif
    SEAM(0);
#pragma unroll 1
    for (int l = 0; l < 2; ++l) {
        const int pb = 1 + 7 * l;
#ifndef NO_G1
        if (IN(pb)) for (int rep_ = 0; rep_ < REP_G1; ++rep_) {
            FRESH(); float* ssq = (float*)(ws + WS_SSQ); const float* ropec = (const float*)(ws + WS_ROPE);
            pg8::Gemm g{(const bf16*)(ws + WS_XB), (const bf16*)(ws + WS_W + (size_t)l * WL_STRIDE + WO_IN), TOK, INCOLS, DMODEL}; pg8::StaticOrder S; S.init(TOK, INCOLS, F.G, (int)blockIdx.x);
            pg8::EpiInProj E{ssq + (size_t)(2 * l) * TOK, (bf16*)(ws + WS_Q), (bf16*)(ws + WS_K), (bf16*)(ws + WS_V), (bf16*)(ws + WS_ZR), P->q_norm + l * 64, P->k_norm + l * 64, ropec, ropec + 256 * 16};
            pg8::gemm_phase<pg8::EpiInProj, pg8::StaticOrder, PG8_ALIGN, PG8_SP2>(F.lds, g, S, E);
        }
#endif
        SEAM(pb);
#ifndef NO_HG1
        if (IN(pb + 1)) { for (int rep_ = 0; rep_ < REP_HG1; ++rep_) { FRESH(); hg_local(F, P, l); }
            if (l == 0) { FRESH(); p0_weights(F, P, (LAS float*)(F.lds + F.wave * HG_WAVE_BYTES), I_IN, I_L); } }
#endif
        SEAM(pb + 1);
#ifndef NO_HG2
        if (IN(pb + 2)) { for (int rep_ = 0; rep_ < REP_HG2; ++rep_) { FRESH(); hg_scan(F, P); }
            if (l == 0) { FRESH(); p0_weights(F, P, (LAS float*)(F.lds + F.wave * HG_WAVE_BYTES), I_L, 2 * I_L); } }
#endif
        SEAM(pb + 2);
        if (IN(pb + 3)) {
#ifndef NO_ATTN
            for (int rep_ = 0; rep_ < REP_ATTN; ++rep_) { FRESH(); attn_body::attn_phase<8>((char*)lds, (const attn_body::bf16*)(ws + WS_Q), (const attn_body::bf16*)(ws + WS_K), (const attn_body::bf16*)(ws + WS_V), (attn_body::bf16*)(ws + WS_MIX), F.vcu, F.G); }
#endif
            __syncthreads();
#ifndef NO_HG3
            for (int rep_ = 0; rep_ < REP_HG3; ++rep_) { FRESH(); hg_out(F, P, l); }
#endif
            __syncthreads();
#ifndef NO_CONV
            for (int rep_ = 0; rep_ < REP_CONV; ++rep_) { FRESH(); conv_phase(F, P, l); }
#endif
        }
        SEAM(pb + 3);
#ifndef NO_G2
        if (IN(pb + 4)) {
            FRESH(); float* ssq = (float*)(ws + WS_SSQ);
            pg8::Gemm g{(const bf16*)(ws + WS_MIX), (const bf16*)(ws + WS_W + (size_t)l * WL_STRIDE + WO_OUT), TOK, DMODEL, DMODEL}; pg8::StaticOrder S; S.init(TOK, DMODEL, F.G, (int)blockIdx.x);
            pg8::EpiResid E{l == 0 ? P->x : (const float*)P->out, P->out, (bf16*)(ws + WS_XB), ssq + (size_t)(2 * l + 1) * TOK};
            pg8::gemm_phase<pg8::EpiResid, pg8::StaticOrder, PG8_ALIGN, PG8_SP2>(F.lds, g, S, E);
        }
#endif
        SEAM(pb + 4);
#ifndef NO_G3
        if (IN(pb + 5)) for (int rep_ = 0; rep_ < REP_G3; ++rep_) {
            FRESH(); float* ssq = (float*)(ws + WS_SSQ);
            pg8::Gemm g{(const bf16*)(ws + WS_XB), (const bf16*)(ws + WS_W + (size_t)l * WL_STRIDE + WO_1), TOK, DFF, DMODEL}; pg8::StaticOrder S; S.init(TOK, DFF, F.G, (int)blockIdx.x);
            pg8::EpiMlpIn E{ssq + (size_t)(2 * l + 1) * TOK, (bf16*)(ws + WS_HID)};
            pg8::gemm_phase<pg8::EpiMlpIn, pg8::StaticOrder, PG8_ALIGN, PG8_SP2>(F.lds, g, S, E);
        }
#endif
        SEAM(pb + 5);
#ifndef NO_G4
        if (IN(pb + 6)) {
            FRESH(); float* ssq = (float*)(ws + WS_SSQ);
            pg8::Gemm g{(const bf16*)(ws + WS_HID), (const bf16*)(ws + WS_W + (size_t)l * WL_STRIDE + WO_2), TOK, DMODEL, DFF}; pg8::StaticOrder S; S.init(TOK, DMODEL, F.G, (int)blockIdx.x);
            pg8::EpiResid E{P->out, P->out, l == 0 ? (bf16*)(ws + WS_XB) : (bf16*)nullptr, l == 0 ? ssq + (size_t)2 * TOK : (float*)nullptr};
            pg8::gemm_phase<pg8::EpiResid, pg8::StaticOrder, PG8_ALIGN, PG8_SP2>(F.lds, g, S, E);
        }
#endif
        SEAM(pb + 6);
    }
#undef IN
#undef SEAM
#undef FRESH
}

extern "C" void kernel_launch(void* const* d_in, const int* in_sizes, int n_in, void* d_out, int out_size, void* d_ws, size_t ws_size, hipStream_t stream) {
    static int grid = 0;
    if (grid == 0) {
        if (n_in != 16 || in_sizes[0] != TOK * DMODEL || out_size != TOK * DMODEL || ws_size < WS_END) {
            fprintf(stderr, "kernel_launch: unexpected shapes / workspace (n_in %d, in0 %d, out %d, ws %zu, need %zu); nothing launched\n", n_in, n_in > 0 ? in_sizes[0] : -1, out_size, ws_size, (size_t)WS_END); grid = -1; return; }
        int dev = 0, cus = 0, per_cu = 0;
        if (hipGetDevice(&dev) != hipSuccess || hipDeviceGetAttribute(&cus, hipDeviceAttributeMultiprocessorCount, dev) != hipSuccess) { grid = -1; return; }
        if (hipFuncSetAttribute((const void*)fwd_kernel, hipFuncAttributeMaxDynamicSharedMemorySize, LDS_BYTES) != hipSuccess) { fprintf(stderr, "kernel_launch: hipFuncSetAttribute failed\n"); grid = -1; return; }
        if (hipOccupancyMaxActiveBlocksPerMultiprocessor(&per_cu, (const void*)fwd_kernel, NWAVES * 64, LDS_BYTES) != hipSuccess || per_cu < 1) { fprintf(stderr, "kernel_launch: occupancy query says %d blocks per CU\n", per_cu); per_cu = 1; }
        (void)hipGetLastError();
        grid = cus * per_cu;
    }
    if (grid < 0) return;
    if (hipMemsetAsync((char*)d_ws + WS_BAR, 0, BAR_ZERO_BYTES, stream) != hipSuccess) { fprintf(stderr, "kernel_launch: memset of the barrier words failed\n"); return; }
    Params p{};
    const float** pp = (const float**)&p;
    for (int i = 0; i < 16; ++i) pp[i] = (const float*)d_in[i];
    p.out = (float*)d_out; p.ws = (unsigned char*)d_ws;
#if MK_SPLIT
    for (int ph = 0; ph < NPHASE; ++ph) { p.ph_lo = ph; p.ph_hi = ph + 1; hipLaunchKernelGGL(fwd_kernel, dim3(grid), dim3(NWAVES * 64), LDS_BYTES, stream, p); }
#else
#ifndef MK_PH_HI
#define MK_PH_HI NPHASE
#endif
    p.ph_lo = 0; p.ph_hi = MK_PH_HI;
    void* args[] = {&p};
    const hipError_t e = hipLaunchCooperativeKernel((const void*)fwd_kernel, dim3(grid), dim3(NWAVES * 64), args, LDS_BYTES, stream);
    if (e != hipSuccess) fprintf(stderr, "kernel_launch: cooperative launch failed: %s (grid %d)\n", hipGetErrorString(e), grid);
#endif
}
```

```cpp
#include <hip/hip_runtime.h>
#include <hip/hip_bf16.h>
#include <hip/hip_cooperative_groups.h>
#include <cstdio>
#include <cstdint>
#include <cmath>
namespace cg = cooperative_groups;

constexpr int TOK = 32768, SEQL = 16384, DMODEL = 1024, INCOLS = 2560, DFF = 4096, ZRP = 1792;
constexpr float EPS = 1e-6f;
constexpr float QSCALE = 0.125f * 1.4426950408889634f;

namespace pg8 {
#define PG8_LAS __attribute__((address_space(3)))
typedef unsigned short bf16_t;
typedef short bf16x8 __attribute__((ext_vector_type(8)));
typedef float f32x4 __attribute__((ext_vector_type(4)));
typedef unsigned u32x4 __attribute__((ext_vector_type(4)));
constexpr int BM = 256, BK = 64, HALF = 128, HTB = HALF * BK * 2  , STAGE_BYTES = 8 * HTB, NXCD = 8, WGM = 8;

__host__ __device__ __forceinline__ int lds_byte(int r, int c) { const int st = (r >> 4) * 2 + (c >> 5), rr = r & 15, cc = c & 31, ob = rr * 64 + cc * 2; return st * 1024 + (ob ^ (((ob >> 9) & 1) << 5)); }
__host__ __device__ __forceinline__ void stage_rc(int b, int& R, int& C) { const int st = b / 1024, sb = b % 1024, swz = sb ^ (((sb >> 9) & 1) << 5); R = (st >> 1) * 16 + swz / 64; C = (st & 1) * 32 + (swz % 64) / 2; }
__host__ __device__ __forceinline__ int perm32(int rho) { const int n = rho >> 4, i = rho & 15; return 8 * (i >> 2) + 4 * n + (i & 3); }

struct Unit { int pm, pn; };
struct Gemm { const bf16_t* A; const bf16_t* Bt; int M, N, K; };

struct StaticOrder {
    int nM, nN, nwg, G, c;
    __host__ __device__ void init(int M, int N, int G_, int c_) { nM = M / BM; nN = N / BM; nwg = nM * nN; G = G_; c = c_; }
    __host__ __device__ bool next(int i, Unit& u) const {
        const long L = (long)i * G + c; if (L >= nwg) return false;
        int wgid = (int)L; { const int q = nwg / NXCD, r = nwg % NXCD, xcd = wgid % NXCD, off = wgid / NXCD; wgid = (xcd < r ? xcd * (q + 1) : r * (q + 1) + (xcd - r) * q) + off; }
        const int nig = WGM * nN, gid = wgid / nig, fm = gid * WGM, gsz = (nM - fm) < WGM ? (nM - fm) : WGM;
        u.pm = fm + ((wgid % nig) % gsz); u.pn = (wgid % nig) / gsz; return true;
    }
    __device__ __forceinline__ void a_ready(const Unit&) const {}
    __device__ __forceinline__ void done(const Unit&) const {}
};
__device__ __forceinline__ unsigned cvt_pk_bf16(float lo, float hi) { unsigned r; asm volatile("v_cvt_pk_bf16_f32 %0, %1, %2" : "=v"(r) : "v"(lo), "v"(hi)); return r; }
typedef float f32x2 __attribute__((ext_vector_type(2)));
typedef unsigned u32x2 __attribute__((ext_vector_type(2)));
__device__ __forceinline__ float rsq(float x) { return __builtin_amdgcn_rsqf(x); }
__device__ __forceinline__ float dot4(f32x4 a) { return (a[0] * a[0] + a[1] * a[1]) + (a[2] * a[2] + a[3] * a[3]); }

struct EpiInProj {
    static constexpr bool PERM = false, AFTER_DRAIN = false;
    const float* ssq; bf16_t* Q; bf16_t* Kb; bf16_t* Vb; bf16_t* ZR; const float* qg; const float* kg; const float* ropec; const float* ropes;
    __device__ __forceinline__ void operator()(const f32x4 (&acc)[2][2][4][2], const Unit& u, int wr, int wc, int fr, int fq) const {
        const int row0 = u.pm * BM + wr * 64 + fr;
        if (u.pn >= 3) {
            const int col0 = (u.pn - 3) * 256 + wc * 32 + 8 * fq;
#pragma unroll
            for (int ai = 0; ai < 2; ++ai)
#pragma unroll
                for (int m = 0; m < 4; ++m) {
                    const int row = row0 + ai * HALF + m * 16;
                    const float rinv = rsq(ssq[row] * (1.f / 1024.f) + EPS);
                    bf16_t* rowp = ZR + (size_t)row * ZRP + col0;
#pragma unroll
                    for (int bj = 0; bj < 2; ++bj) { const f32x4 v0 = acc[ai][bj][m][0] * rinv, v1 = acc[ai][bj][m][1] * rinv;
                        u32x4 w; w.x = cvt_pk_bf16(v0[0], v0[1]); w.y = cvt_pk_bf16(v0[2], v0[3]); w.z = cvt_pk_bf16(v1[0], v1[1]); w.w = cvt_pk_bf16(v1[2], v1[3]);
                        *(u32x4*)(rowp + bj * HALF) = w; }
                }
        } else {
            const int hh = 4 * u.pn + wc;
            const bool isq = hh < 8, isk = (hh >= 8 && hh < 10), nrm = isq || isk;
            bf16_t* dst; int pitch;
            if (isq) { dst = Q + hh * 64; pitch = 512; } else if (isk) { dst = Kb + (hh - 8) * 64; pitch = 128; } else { dst = Vb + (hh - 10) * 64; pitch = 128; }
            const float* gp = isq ? qg : kg;
            f32x4 gv[2][2];
#pragma unroll
            for (int bj = 0; bj < 2; ++bj)
#pragma unroll
                for (int n = 0; n < 2; ++n) gv[bj][n] = *(const f32x4*)(gp + 32 * bj + 16 * n + 4 * fq);
            const float osc = isq ? QSCALE : 1.f;
#pragma unroll
            for (int ai = 0; ai < 2; ++ai)
#pragma unroll
                for (int m = 0; m < 4; ++m) {
                    const int row = row0 + ai * HALF + m * 16;
                    const float rinv = rsq(ssq[row] * (1.f / 1024.f) + EPS);
                    f32x4 v[2][2]; float ss = 0.f;
#pragma unroll
                    for (int bj = 0; bj < 2; ++bj)
#pragma unroll
                        for (int n = 0; n < 2; ++n) { v[bj][n] = acc[ai][bj][m][n] * rinv; ss += dot4(v[bj][n]); }
                    if (nrm) {
                        ss += __shfl_xor(ss, 16); ss += __shfl_xor(ss, 32);
                        const float rn = rsq(ss * (1.f / 64.f) + EPS);
                        const int t = row & (SEQL - 1);
#pragma unroll
                        for (int bj = 0; bj < 2; ++bj) { const int pos = bj ? (t & 63) : (t >> 6);
                            const f32x4 c4 = *(const f32x4*)(ropec + pos * 16 + 4 * fq), s4 = *(const f32x4*)(ropes + pos * 16 + 4 * fq);
                            const f32x4 x1 = v[bj][0] * rn * gv[bj][0], x2 = v[bj][1] * rn * gv[bj][1];
                            v[bj][0] = (x1 * c4 - x2 * s4) * osc; v[bj][1] = (x1 * s4 + x2 * c4) * osc; }
                    }
                    bf16_t* rowp = dst + (size_t)row * pitch + 4 * fq;
#pragma unroll
                    for (int bj = 0; bj < 2; ++bj)
#pragma unroll
                        for (int n = 0; n < 2; ++n) { u32x2 w; w.x = cvt_pk_bf16(v[bj][n][0], v[bj][n][1]); w.y = cvt_pk_bf16(v[bj][n][2], v[bj][n][3]); *(u32x2*)(rowp + 32 * bj + 16 * n) = w; }
                }
        }
    }
};
struct EpiResid {
    static constexpr bool PERM = false, AFTER_DRAIN = false;
    const float* base; float* out; bf16_t* xb; float* ssq;
    __device__ __forceinline__ void operator()(const f32x4 (&acc)[2][2][4][2], const Unit& u, int wr, int wc, int fr, int fq) const {
        const int row0 = u.pm * BM + wr * 64 + fr, col0 = u.pn * BM + wc * 32 + 8 * fq;
#pragma unroll
        for (int ai = 0; ai < 2; ++ai)
#pragma unroll
            for (int m = 0; m < 4; ++m) {
                const int row = row0 + ai * HALF + m * 16; const size_t off = (size_t)row * DMODEL + col0; float s = 0.f;
#pragma unroll
                for (int bj = 0; bj < 2; ++bj) {
                    const f32x4 b0 = *(const f32x4*)(base + off + bj * HALF), b1 = *(const f32x4*)(base + off + bj * HALF + 4);
                    const f32x4 v0 = b0 + acc[ai][bj][m][0], v1 = b1 + acc[ai][bj][m][1];
                    *(f32x4*)(out + off + bj * HALF) = v0; *(f32x4*)(out + off + bj * HALF + 4) = v1;
                    s += dot4(v0) + dot4(v1);
                    if (xb) { u32x4 w; w.x = cvt_pk_bf16(v0[0], v0[1]); w.y = cvt_pk_bf16(v0[2], v0[3]); w.z = cvt_pk_bf16(v1[0], v1[1]); w.w = cvt_pk_bf16(v1[2], v1[3]);
                        *(u32x4*)(xb + off + bj * HALF) = w; }
                }
                if (ssq) { s += __shfl_xor(s, 16); s += __shfl_xor(s, 32); if (fq == 0) atomicAdd(ssq + row, s); }
            }
    }
};
struct EpiMlpIn {
    static constexpr bool PERM = false, AFTER_DRAIN = false;
    const float* ssq; bf16_t* H;
    __device__ __forceinline__ void operator()(const f32x4 (&acc)[2][2][4][2], const Unit& u, int wr, int wc, int fr, int fq) const {
        const int row0 = u.pm * BM + wr * 64 + fr, col0 = u.pn * BM + wc * 32 + 8 * fq;
#pragma unroll
        for (int ai = 0; ai < 2; ++ai)
#pragma unroll
            for (int m = 0; m < 4; ++m) {
                const int row = row0 + ai * HALF + m * 16;
                const float rinv = rsq(ssq[row] * (1.f / 1024.f) + EPS);
                bf16_t* rowp = H + (size_t)row * DFF + col0;
#pragma unroll
                for (int bj = 0; bj < 2; ++bj) { f32x4 v0 = acc[ai][bj][m][0] * rinv, v1 = acc[ai][bj][m][1] * rinv;
#pragma unroll
                    for (int j = 0; j < 4; ++j) { const float a = fmaxf(v0[j], 0.f), b = fmaxf(v1[j], 0.f); v0[j] = a * a; v1[j] = b * b; }
                    u32x4 w; w.x = cvt_pk_bf16(v0[0], v0[1]); w.y = cvt_pk_bf16(v0[2], v0[3]); w.z = cvt_pk_bf16(v1[0], v1[1]); w.w = cvt_pk_bf16(v1[2], v1[3]);
                    *(u32x4*)(rowp + bj * HALF) = w; }
            }
    }
};


template <class Epi, class Sched, bool ALIGN_EPI = false, bool SP2 = false>
__device__ __forceinline__ void gemm_phase(PG8_LAS unsigned char* lds, const Gemm g, const Sched& S, const Epi& E) {
    int tid_ = threadIdx.x; asm volatile("" : "+v"(tid_));
    const int tid = tid_, wid = __builtin_amdgcn_readfirstlane(tid >> 6), lane = tid & 63, wr = wid >> 2, wc = wid & 3, fr = lane & 15, fq = lane >> 4;
    const int K = g.K, nt = K / BK;
    unsigned voffA[2], voffB[2];
#pragma unroll
    for (int i = 0; i < 2; ++i) { int R, C; stage_rc(tid * 16 + i * 8192, R, C); const int Rb = Epi::PERM ? ((R & ~31) + perm32(R & 31)) : R;
        voffA[i] = (unsigned)(R * K + C) * 2u; voffB[i] = (unsigned)(Rb * K + C) * 2u; }
    const size_t kstep = (size_t)(BK * 2);
    const size_t hstep = (size_t)HALF * K * 2;
    const size_t tstep = 2 * hstep;
    const unsigned ldsw = (unsigned)wid * 1024u;
    const int aoff = lds_byte(wr * 64 + fr, fq * 8), boff = lds_byte(wc * 32 + fr, fq * 8);
#define PG8_SA(b, h) (((b) * 2 + (h)) * HTB)
#define PG8_SB(b, h) ((4 + (b) * 2 + (h)) * HTB)
#define PG8_STAGE(bufoff, gbase, voff) do { _Pragma("unroll") for (int _i = 0; _i < 2; ++_i) \
        __builtin_amdgcn_global_load_lds((const unsigned*)((const char*)(gbase) + (voff)[_i]), (PG8_LAS unsigned*)(lds + (bufoff) + ldsw + _i * 8192), 16, 0, 0); } while (0)
#define PG8_LDA(dst, b, h) do { _Pragma("unroll") for (int m = 0; m < 4; ++m) _Pragma("unroll") for (int k = 0; k < 2; ++k) dst[m][k] = *(const PG8_LAS bf16x8*)(lds + PG8_SA(b, h) + aoff + m * 2048 + k * 1024); } while (0)
#define PG8_LDB(dst, b, h) do { _Pragma("unroll") for (int n = 0; n < 2; ++n) _Pragma("unroll") for (int k = 0; k < 2; ++k) dst[n][k] = *(const PG8_LAS bf16x8*)(lds + PG8_SB(b, h) + boff + n * 2048 + k * 1024); } while (0)
#define PG8_MMA(ai, bj, At, Bt) do { __builtin_amdgcn_s_setprio(1); _Pragma("unroll") for (int m = 0; m < 4; ++m) _Pragma("unroll") for (int n = 0; n < 2; ++n) _Pragma("unroll") for (int k = 0; k < 2; ++k) \
        acc[ai][bj][m][n] = __builtin_amdgcn_mfma_f32_16x16x32_bf16(Bt[n][k], At[m][k], acc[ai][bj][m][n], 0, 0, 0); __builtin_amdgcn_s_setprio(0); } while (0)
#define PG8_WAIT_V(n) asm volatile("s_waitcnt vmcnt(" #n ")" ::: "memory")
#define PG8_WAIT_L(n) asm volatile("s_waitcnt lgkmcnt(" #n ")" ::: "memory")
#define PG8_BAR __builtin_amdgcn_s_barrier()
#define PG8_SCHED __builtin_amdgcn_sched_barrier(0)
    Unit cur, nxt; int ui = 0;
    if (!S.next(0, cur)) return;
    f32x4 acc[2][2][4][2];
#pragma unroll
    for (int a = 0; a < 2; ++a)
#pragma unroll
        for (int b = 0; b < 2; ++b)
#pragma unroll
            for (int m = 0; m < 4; ++m)
#pragma unroll
                for (int n = 0; n < 2; ++n) acc[a][b][m][n] = (f32x4){0.f, 0.f, 0.f, 0.f};
    bf16x8 At[4][2], B0[2][2], B1[2][2];
    const char* cA = (const char*)g.A + (size_t)cur.pm * tstep; const char* cB = (const char*)g.Bt + (size_t)cur.pn * tstep;
    S.a_ready(cur);
    if constexpr (SP2) {
        PG8_STAGE(PG8_SB(0, 0), cB, voffB); PG8_STAGE(PG8_SB(0, 1), cB + hstep, voffB); PG8_STAGE(PG8_SA(0, 0), cA, voffA); PG8_STAGE(PG8_SA(0, 1), cA + hstep, voffA);
        if (wr == 1) PG8_BAR;
        PG8_WAIT_V(2); PG8_BAR;
        PG8_STAGE(PG8_SB(1, 0), cB + kstep, voffB); PG8_STAGE(PG8_SA(1, 0), cA + kstep, voffA); PG8_STAGE(PG8_SB(1, 1), cB + hstep + kstep, voffB);
        PG8_WAIT_V(6); PG8_BAR;
    } else {
        PG8_STAGE(PG8_SB(0, 0), cB, voffB); PG8_STAGE(PG8_SA(0, 0), cA, voffA); PG8_STAGE(PG8_SB(0, 1), cB + hstep, voffB); PG8_STAGE(PG8_SA(0, 1), cA + hstep, voffA);
        if (wr == 1) PG8_BAR;
        PG8_WAIT_V(4); PG8_BAR;
        PG8_STAGE(PG8_SB(1, 0), cB + kstep, voffB); PG8_STAGE(PG8_SA(1, 0), cA + kstep, voffA); PG8_STAGE(PG8_SB(1, 1), cB + hstep + kstep, voffB);
        PG8_WAIT_V(6); PG8_BAR;
    }
    for (;;) {
        const bool has_next = S.next(ui + 1, nxt);
        const char* nA = has_next ? (const char*)g.A + (size_t)nxt.pm * tstep : cA; const char* nB = has_next ? (const char*)g.Bt + (size_t)nxt.pn * tstep : cB;
        for (int t = 0; t < nt; t += 2) {
            const bool last = (t == nt - 2);
            const char* a1 = cA + (size_t)(t + 1) * kstep;
            const char* a2 = last ? nA : cA + (size_t)(t + 2) * kstep; const char* b2 = last ? nB : cB + (size_t)(t + 2) * kstep;
            const char* a3 = a2 + kstep; const char* b3 = b2 + kstep;
            if (last && has_next) S.a_ready(nxt);
            if constexpr (SP2) {
            PG8_LDB(B0, 0, 0); PG8_LDB(B1, 0, 1); PG8_SCHED; PG8_LDA(At, 0, 0); PG8_STAGE(PG8_SA(1, 1), a1 + hstep, voffA);
            PG8_WAIT_V(8); PG8_WAIT_L(0); PG8_BAR; PG8_MMA(0, 0, At, B0); PG8_MMA(0, 1, At, B1); PG8_BAR; PG8_SCHED;
            PG8_LDA(At, 0, 1); PG8_STAGE(PG8_SB(0, 0), b2, voffB); PG8_STAGE(PG8_SB(0, 1), b2 + hstep, voffB); PG8_STAGE(PG8_SA(0, 0), a2, voffA);
            PG8_WAIT_V(8); PG8_WAIT_L(0); PG8_BAR; PG8_MMA(1, 0, At, B0); PG8_MMA(1, 1, At, B1); PG8_BAR; PG8_SCHED;
            PG8_LDB(B0, 1, 0); PG8_LDB(B1, 1, 1); PG8_SCHED; PG8_LDA(At, 1, 0); PG8_STAGE(PG8_SA(0, 1), a2 + hstep, voffA);
            PG8_WAIT_V(8); PG8_WAIT_L(0); PG8_BAR; PG8_MMA(0, 0, At, B0); PG8_MMA(0, 1, At, B1); PG8_BAR; PG8_SCHED;
            PG8_LDA(At, 1, 1); PG8_STAGE(PG8_SB(1, 0), b3, voffB); PG8_STAGE(PG8_SB(1, 1), b3 + hstep, voffB); PG8_STAGE(PG8_SA(1, 0), a3, voffA);
            PG8_WAIT_V(8); PG8_WAIT_L(0); PG8_BAR; PG8_MMA(1, 0, At, B0); PG8_MMA(1, 1, At, B1); PG8_BAR; PG8_SCHED;
            } else {
            PG8_LDB(B0, 0, 0); PG8_SCHED; PG8_LDA(At, 0, 0); PG8_STAGE(PG8_SA(1, 1), a1 + hstep, voffA);
            PG8_WAIT_L(8); PG8_BAR; PG8_WAIT_L(0); PG8_MMA(0, 0, At, B0); PG8_BAR; PG8_SCHED;
            PG8_LDB(B1, 0, 1); PG8_STAGE(PG8_SB(0, 0), b2, voffB);
            PG8_BAR; PG8_WAIT_L(0); PG8_MMA(0, 1, At, B1); PG8_BAR;
            PG8_LDA(At, 0, 1); PG8_STAGE(PG8_SA(0, 0), a2, voffA);
            PG8_BAR; PG8_WAIT_L(0); PG8_MMA(1, 0, At, B0); PG8_BAR; PG8_SCHED;
            PG8_STAGE(PG8_SB(0, 1), b2 + hstep, voffB);
            PG8_WAIT_V(6); PG8_BAR; PG8_MMA(1, 1, At, B1); PG8_BAR;
            PG8_LDB(B0, 1, 0); PG8_SCHED; PG8_LDA(At, 1, 0); PG8_STAGE(PG8_SA(0, 1), a2 + hstep, voffA);
            PG8_WAIT_L(8); PG8_BAR; PG8_WAIT_L(0); PG8_MMA(0, 0, At, B0); PG8_BAR; PG8_SCHED;
            PG8_LDB(B1, 1, 1); PG8_STAGE(PG8_SB(1, 0), b3, voffB);
            PG8_BAR; PG8_WAIT_L(0); PG8_MMA(0, 1, At, B1); PG8_BAR;
            PG8_LDA(At, 1, 1); PG8_STAGE(PG8_SA(1, 0), a3, voffA);
            PG8_BAR; PG8_WAIT_L(0); PG8_MMA(1, 0, At, B0); PG8_BAR; PG8_SCHED;
            PG8_STAGE(PG8_SB(1, 1), b3 + hstep, voffB);
            PG8_WAIT_V(6); PG8_BAR; PG8_MMA(1, 1, At, B1); PG8_BAR;
            }
        }
        if constexpr (ALIGN_EPI) { if (wr == 0) PG8_BAR; }
        if constexpr (!Epi::AFTER_DRAIN) { E(acc, cur, wr, wc, fr, fq); S.done(cur); }
        if (!has_next) break;
#pragma unroll
        for (int a = 0; a < 2; ++a)
#pragma unroll
            for (int b = 0; b < 2; ++b)
#pragma unroll
                for (int m = 0; m < 4; ++m)
#pragma unroll
                    for (int n = 0; n < 2; ++n) acc[a][b][m][n] = (f32x4){0.f, 0.f, 0.f, 0.f};
        cur = nxt; cA = nA; cB = nB; ++ui;
        if constexpr (ALIGN_EPI) { if (wr == 1) PG8_BAR; }
    }
    PG8_WAIT_V(0);
    if constexpr (!ALIGN_EPI) { if (wr == 0) PG8_BAR; }
    PG8_BAR;
    if constexpr (Epi::AFTER_DRAIN) { E.fused(acc, cur, wr, wc, fr, fq, lds, wid, lane); S.done(cur); }
#undef PG8_SA
#undef PG8_SB
#undef PG8_STAGE
#undef PG8_LDA
#undef PG8_LDB
#undef PG8_MMA
#undef PG8_WAIT_V
#undef PG8_WAIT_L
#undef PG8_BAR
#undef PG8_SCHED
}
}
#define PG8_SP2 true
#define PG8_ALIGN true
#include <hip/hip_bf16.h>
#include <cmath>
namespace attn_body {
using bf16=__hip_bfloat16;
using bf16x8=__attribute__((ext_vector_type(8)))short;
using s16x4=__attribute__((ext_vector_type(4)))short;
using f32x16=__attribute__((ext_vector_type(16)))float;
using u32x4=__attribute__((ext_vector_type(4)))unsigned;
constexpr int BATCH=2,NHEAD=8,SEQ=16384,D=64,QP=512,KP=128,OP=1024;
constexpr int NW=8,QBLK=32,QB=QBLK*NW,KVBLK=64,NQB=SEQ/QB;
constexpr int ATTN_UNIT_ROWS=QB;
__device__ __forceinline__ int crow(int r,int hi){return (r&3)+8*(r>>2)+4*hi;}
#define SBAR() __builtin_amdgcn_sched_barrier(0)
__device__ __forceinline__ void cmask(f32x16&p0,f32x16&p1,int jb,int qrel,int hi){
  const float NEG=-INFINITY; int kb=64*jb+4*hi;
  #pragma unroll
  for(int r=0;r<16;++r){int kv=kb+(r&3)+8*(r>>2); if(kv>qrel)p0[r]=NEG; if(kv+32>qrel)p1[r]=NEG;}
}

constexpr bool ATTN_NOMAX=true;
constexpr int NSLOT=3, SLOTB=8192;
constexpr int LDS_K=0, LDS_V=NSLOT*SLOTB, LDS_WS=2*NSLOT*SLOTB, LDS_OST=LDS_WS+NW*64*4, LDS_BYTES=LDS_OST+NW*4096;
constexpr float C2=0.125f*1.4426950408889634f;
__device__ __forceinline__ void glds16(const void*gsrc,unsigned lds_dst){unsigned keep;
  asm volatile("s_mov_b32 %0, m0\n\ts_mov_b32 m0, %2\n\ts_nop 0\n\tglobal_load_lds_dwordx4 %1, off\n\ts_mov_b32 m0, %0":"=&s"(keep):"v"(gsrc),"s"(lds_dst):"memory");}
__device__ __forceinline__ float max3f(float a,float b,float c){float r;asm("v_max3_f32 %0, %1, %2, %3":"=v"(r):"v"(a),"v"(b),"v"(c));return r;}
__device__ __forceinline__ float max2f(float a,float b){float r;asm("v_max_f32_e32 %0, %1, %2":"=v"(r):"v"(a),"v"(b));return r;}
__device__ __forceinline__ float fadd_s(float a,float b){float r;asm("v_add_f32_e32 %0, %1, %2":"=v"(r):"v"(a),"v"(b));return r;}
__device__ __forceinline__ float fsub_s(float a,float b){float r;asm("v_sub_f32_e32 %0, %1, %2":"=v"(r):"v"(a),"v"(b));return r;}
typedef float f32x2_t __attribute__((ext_vector_type(2))); typedef __bf16 bf16x2_t __attribute__((ext_vector_type(2)));
__device__ __forceinline__ unsigned cvtpk_s(float lo,float hi){f32x2_t v={lo,hi};bf16x2_t b=__builtin_convertvector(v,bf16x2_t);return __builtin_bit_cast(unsigned,b);}
#define WAIT_BAR(N) asm volatile("s_waitcnt vmcnt(" #N ") lgkmcnt(0)\n\ts_barrier":::"memory")

__device__ __forceinline__ void qkt(f32x16&p0,f32x16&p1,const char*Kslot,const bf16x8*qr,const f32x16&negm,int r32,int hi){
  const char*kb=Kslot+hi*1024+r32*16;
  #pragma unroll
  for(int d0=0;d0<4;++d0){
    const bf16x8 b0=*reinterpret_cast<const bf16x8*>(kb+d0*2048);
    const bf16x8 b1=*reinterpret_cast<const bf16x8*>(kb+d0*2048+512);
    if(d0==0){p0=__builtin_amdgcn_mfma_f32_32x32x16_bf16(b0,qr[0],negm,0,0,0);p1=__builtin_amdgcn_mfma_f32_32x32x16_bf16(b1,qr[0],negm,0,0,0);}
    else{p0=__builtin_amdgcn_mfma_f32_32x32x16_bf16(b0,qr[d0],p0,0,0,0);p1=__builtin_amdgcn_mfma_f32_32x32x16_bf16(b1,qr[d0],p1,0,0,0);}}
}
typedef __attribute__((address_space(3))) const char* lds_cptr;
typedef short v4i16_t __attribute__((ext_vector_type(4)));
__device__ __forceinline__ void kload8(bf16x8*kf,lds_cptr kp){
  kf[0]=*(const __attribute__((address_space(3))) bf16x8*)(kp);      kf[1]=*(const __attribute__((address_space(3))) bf16x8*)(kp+512);
  kf[2]=*(const __attribute__((address_space(3))) bf16x8*)(kp+2048); kf[3]=*(const __attribute__((address_space(3))) bf16x8*)(kp+2560);
  kf[4]=*(const __attribute__((address_space(3))) bf16x8*)(kp+4096); kf[5]=*(const __attribute__((address_space(3))) bf16x8*)(kp+4608);
  kf[6]=*(const __attribute__((address_space(3))) bf16x8*)(kp+6144); kf[7]=*(const __attribute__((address_space(3))) bf16x8*)(kp+6656);
}
__device__ __forceinline__ void kload2(bf16x8*kf,lds_cptr kp,int j){ kf[2*j]=*(const __attribute__((address_space(3))) bf16x8*)(kp+j*2048); kf[2*j+1]=*(const __attribute__((address_space(3))) bf16x8*)(kp+j*2048+512); }
__device__ __forceinline__ s16x4 vtr(lds_cptr p){ return __builtin_bit_cast(s16x4,__builtin_amdgcn_ds_read_tr16_b64_v4i16((__attribute__((address_space(3))) v4i16_t*)p)); }
__device__ __forceinline__ float rowmax(const f32x16&p0,const f32x16&p1){
  float a=max3f(p0[0],p0[1],p1[0]),b=max3f(p0[2],p0[3],p1[1]);a=max3f(a,p1[2],p1[3]);
  #pragma unroll
  for(int r=4;r<16;r+=4){a=max3f(a,p0[r],p0[r+1]);b=max3f(b,p0[r+2],p0[r+3]);a=max3f(a,p1[r],p1[r+1]);b=max3f(b,p1[r+2],p1[r+3]);}
  const float m=max2f(a,b);
  auto rr=__builtin_amdgcn_permlane32_swap(__float_as_uint(m),__float_as_uint(m),false,false);
  return max2f(__uint_as_float(rr[0]),__uint_as_float(rr[1]));
}
__device__ __forceinline__ void pv(f32x16*o,int vb,bf16x8 pa0,bf16x8 pa1,bf16x8 pa2,bf16x8 pa3){
  #pragma unroll
  for(int d0=0;d0<2;++d0){s16x4 lo[4],hi[4];
    #pragma unroll
    for(int ks=0;ks<4;++ks){
      asm volatile("ds_read_b64_tr_b16 %0,%1 offset:%c2":"=&v"(lo[ks]):"v"(vb),"i"(d0*4096+ks*1024):"memory");
      asm volatile("ds_read_b64_tr_b16 %0,%1 offset:%c2":"=&v"(hi[ks]):"v"(vb),"i"(d0*4096+ks*1024+512):"memory");}
    asm volatile("s_waitcnt lgkmcnt(0)":::"memory");SBAR();
    #define PK(k) (bf16x8){lo[k][0],lo[k][1],lo[k][2],lo[k][3],hi[k][0],hi[k][1],hi[k][2],hi[k][3]}
    o[d0]=__builtin_amdgcn_mfma_f32_32x32x16_bf16(pa0,PK(0),o[d0],0,0,0);
    o[d0]=__builtin_amdgcn_mfma_f32_32x32x16_bf16(pa1,PK(1),o[d0],0,0,0);
    o[d0]=__builtin_amdgcn_mfma_f32_32x32x16_bf16(pa2,PK(2),o[d0],0,0,0);
    o[d0]=__builtin_amdgcn_mfma_f32_32x32x16_bf16(pa3,PK(3),o[d0],0,0,0);
    #undef PK
  }
}

#ifndef ATTN_STORE16
#define ATTN_STORE16(p,v) (*(u32x4*)(p)=(v))
#endif
template<int THRL> __device__ __forceinline__ void attn_unit(int b,int h,int qb,const bf16*Q,const bf16*__restrict__ K,const bf16*__restrict__ V,bf16*O,char*shm){
  int tid_=threadIdx.x; asm volatile("":"+v"(tid_)); const int tid=tid_,lane=tid&63,r32=lane&31,hi=lane>>5; const int wid=__builtin_amdgcn_readfirstlane(tid>>6);
  const long rowbase=(long)b*SEQ; const int q0=qb*QB;
  const bf16*Qw=Q+(rowbase+q0+wid*QBLK)*QP+h*D;
  const bf16*Kh=K+rowbase*KP+(h>>2)*D,*Vh=V+rowbase*KP+(h>>2)*D;
  const unsigned lds0=(unsigned)(uintptr_t)shm;
  float*wsf=(float*)(shm+LDS_WS)+wid*64;
  const bf16*ksrc=Kh+(long)lane*KP+wid*8;
  const bf16*vsrc=Vh+(long)(16*(wid&3)+(lane>>2))*KP+(wid>>2)*32+(lane&3)*8;
  const unsigned kdst=lds0+LDS_K+wid*1024, vdst=lds0+LDS_V+wid*1024;
  #define DMA_K(t,slot) glds16(ksrc+(long)(t)*KVBLK*KP,(unsigned)__builtin_amdgcn_readfirstlane(kdst+(slot)))
  #define DMA_V(t,slot) glds16(vsrc+(long)(t)*KVBLK*KP,(unsigned)__builtin_amdgcn_readfirstlane(vdst+(slot)))
  const int vb0=(int)(lds0+LDS_V)+((lane>>4)&1)*32+(lane&3)*8+(4*hi+((lane&15)>>2))*64;
  const char*Kbase=shm+LDS_K; bf16x8 kf[8];
  const lds_cptr shm3=(lds_cptr)shm; const lds_cptr kp0=shm3+LDS_K+hi*1024+r32*16; const lds_cptr vp0=shm3+LDS_V+((lane>>4)&1)*32+(lane&3)*8+(4*hi+((lane&15)>>2))*64;
  constexpr int NT=SEQ/KVBLK;
  DMA_K(0,0);DMA_V(0,0);DMA_K(1,SLOTB);
  bf16x8 qr[4];
  #pragma unroll
  for(int d0=0;d0<4;++d0)qr[d0]=*reinterpret_cast<const bf16x8*>(&Qw[(long)r32*QP+d0*16+hi*8]);
  float mhat=0.f,l_reg=0.f;f32x16 o[2];o[0]=f32x16{};o[1]=f32x16{};f32x16 negm=f32x16{};asm volatile("":"+v"(negm));
  #define CMASK(P0,P1,t) do{}while(0)
  bool resc=false;
  #define START(P0,P1) do{ resc=false; \
    if(!ATTN_NOMAX){ const float rm=rowmax(P0,P1); const float dl=rm; mhat=fadd_s(mhat,dl); \
      _Pragma("unroll") for(int r=0;r<16;++r){P0[r]=fsub_s(P0[r],dl);P1[r]=fsub_s(P1[r],dl);} \
      _Pragma("unroll") for(int r=0;r<16;++r)negm[r]=-mhat; asm volatile("":"+v"(negm)); } \
    _Pragma("unroll") for(int r=0;r<16;++r)P0[r]=__builtin_amdgcn_exp2f(P0[r]); }while(0)
  #define RESC() do{ if(resc){ asm volatile("s_waitcnt lgkmcnt(0)":::"memory"); \
      _Pragma("unroll") for(int d_=0;d_<2;++d_) _Pragma("unroll") for(int r=0;r<16;++r)o[d_][r]*=wsf[crow(r,hi)]; } }while(0)
  f32x16 pA0,pA1,pB0,pB1;
  int sl_prev=0,sl_cur=0,sl_next=SLOTB;
  #define ROT() do{sl_prev=sl_cur;sl_cur=sl_next;sl_next=(sl_next==(NSLOT-1)*SLOTB)?0:sl_next+SLOTB;}while(0)
  DMA_K(2,2*SLOTB);
  WAIT_BAR(3);
  qkt(pA0,pA1,Kbase,qr,negm,r32,hi);asm volatile("s_nop 15\n\ts_nop 7":"+v"(pA0),"+v"(pA1));CMASK(pA0,pA1,0);
  START(pA0,pA1);
  _Pragma("unroll") for(int r=0;r<16;++r)pA1[r]=__builtin_amdgcn_exp2f(pA1[r]);
  WAIT_BAR(0);
  DMA_K(3,0);DMA_V(1,SLOTB);
  ROT();
  kload8(kf,kp0+sl_cur);
  WAIT_BAR(2);
  s16x4 vlo[8],vhi[8]; u32x4 pw0,pw1,pw2,pw3;
  #define PKW(P,B) cvtpk_s(P[B],P[B+1])
  #define PAF(k) __builtin_bit_cast(bf16x8,pw##k)
  #define VFR(i) (bf16x8){vlo[i][0],vlo[i][1],vlo[i][2],vlo[i][3],vhi[i][0],vhi[i][1],vhi[i][2],vhi[i][3]}
  #define PIN(x) asm volatile("":"+v"(x))
  #define MX3(a,b,c) __builtin_fmaxf(__builtin_fmaxf((a),(b)),(c))
  #define GAPA(MF,A0,A1,A2,A3,W0,W1,PW) do{ MF; sacc+=A0; sacc+=A1; sacc+=A2; sacc+=A3; PIN(sacc); W0; W1; PIN(PW); SBAR(); }while(0)
  #define EX(v) __builtin_amdgcn_exp2f(v)
  #define GAPB(MF,X,B) do{ MF; X[B]=EX(X[B]); X[B+1]=EX(X[B+1]); X[B+2]=EX(X[B+2]); X[B+3]=EX(X[B+3]); PIN(X); SBAR(); }while(0)
  #define VRD(i) do{ vlo[i]=vtr(vp_+(((i)>>2)*4096+((i)&3)*1024)); vhi[i]=vtr(vp_+(((i)>>2)*4096+((i)&3)*1024+512)); }while(0)
  #define KRD(G,j) do{ if(G){ kload2(kf,kp0+sl_next,j); SBAR(); } }while(0)
  #define STEP(C0,C1,P0,P1,t,GK,GV,GL) do{ SBAR(); \
    const lds_cptr vp_=vp0+sl_prev; \
    VRD(0); SBAR(); float sacc=(P0[0]+P0[1]); \
    GAPA(C0=__builtin_amdgcn_mfma_f32_32x32x16_bf16(kf[0],qr[0],negm,0,0,0), P0[2],P0[3],P0[4],P0[5],     pw0[0]=PKW(P0,0), pw0[1]=PKW(P0,2), pw0); \
    VRD(4); SBAR(); GAPA(C1=__builtin_amdgcn_mfma_f32_32x32x16_bf16(kf[1],qr[0],negm,0,0,0), P0[6],P0[7],P0[8],P0[9],     pw0[2]=PKW(P0,4), pw0[3]=PKW(P0,6), pw0); \
    VRD(1); SBAR(); GAPA(C0=__builtin_amdgcn_mfma_f32_32x32x16_bf16(kf[2],qr[1],C0,0,0,0),   P0[10],P0[11],P0[12],P0[13], pw1[0]=PKW(P0,8), pw1[1]=PKW(P0,10), pw1); \
    VRD(5); SBAR(); GAPA(C1=__builtin_amdgcn_mfma_f32_32x32x16_bf16(kf[3],qr[1],C1,0,0,0),   P0[14],P0[15],P1[0],P1[1],   pw1[2]=PKW(P0,12),pw1[3]=PKW(P0,14), pw1); \
    VRD(2); SBAR(); GAPA(C0=__builtin_amdgcn_mfma_f32_32x32x16_bf16(kf[4],qr[2],C0,0,0,0),   P1[2],P1[3],P1[4],P1[5],     pw2[0]=PKW(P1,0), pw2[1]=PKW(P1,2), pw2); \
    VRD(6); SBAR(); GAPA(C1=__builtin_amdgcn_mfma_f32_32x32x16_bf16(kf[5],qr[2],C1,0,0,0),   P1[6],P1[7],P1[8],P1[9],     pw2[2]=PKW(P1,4), pw2[3]=PKW(P1,6), pw2); \
    VRD(3); SBAR(); GAPA(C0=__builtin_amdgcn_mfma_f32_32x32x16_bf16(kf[6],qr[3],C0,0,0,0),   P1[10],P1[11],P1[12],P1[13], pw3[0]=PKW(P1,8), pw3[1]=PKW(P1,10), pw3); \
    VRD(7); SBAR(); GAPA(C1=__builtin_amdgcn_mfma_f32_32x32x16_bf16(kf[7],qr[3],C1,0,0,0),   P1[14],P1[15],0.f,0.f,       pw3[2]=PKW(P1,12),pw3[3]=PKW(P1,14), pw3); \
    l_reg+=sacc; \
    if(GK){DMA_K((t)+3,sl_cur);} if(GV){DMA_V((t)+1,sl_next);} \
    CMASK(C0,C1,t); \
    resc=false; \
    if(!ATTN_NOMAX){ float a=MX3(C0[0],C0[1],C1[0]),b=MX3(C0[2],C0[3],C1[1]); a=MX3(a,C1[2],C1[3]); \
      _Pragma("unroll") for(int r=4;r<16;r+=4){a=MX3(a,C0[r],C0[r+1]);b=MX3(b,C0[r+2],C0[r+3]);a=MX3(a,C1[r],C1[r+1]);b=MX3(b,C1[r+2],C1[r+3]);} \
      float rm=__builtin_fmaxf(a,b); { auto rr=__builtin_amdgcn_permlane32_swap(__float_as_uint(rm),__float_as_uint(rm),false,false); rm=__builtin_fmaxf(__uint_as_float(rr[0]),__uint_as_float(rr[1])); } \
      resc=false; \
      if(__builtin_expect(__any(rm>(float)THRL),0)){ const float dl=__builtin_fmaxf(rm,0.f); mhat+=dl; \
        _Pragma("unroll") for(int r=0;r<16;++r){C0[r]-=dl;C1[r]-=dl;} \
        _Pragma("unroll") for(int r=0;r<16;++r)negm[r]=-mhat; asm volatile("":"+v"(negm)); \
        const float f=__builtin_amdgcn_exp2f(-dl); l_reg*=f; if(hi==0)wsf[r32]=f; resc=true; } } \
    SBAR(); \
    GAPB(o[0]=__builtin_amdgcn_mfma_f32_32x32x16_bf16(PAF(0),VFR(0),o[0],0,0,0), C0,0); \
    GAPB(o[1]=__builtin_amdgcn_mfma_f32_32x32x16_bf16(PAF(0),VFR(4),o[1],0,0,0), C0,4); \
    KRD(GL,0); GAPB(o[0]=__builtin_amdgcn_mfma_f32_32x32x16_bf16(PAF(1),VFR(1),o[0],0,0,0), C0,8); \
    KRD(GL,1); GAPB(o[1]=__builtin_amdgcn_mfma_f32_32x32x16_bf16(PAF(1),VFR(5),o[1],0,0,0), C0,12); \
    KRD(GL,2); GAPB(o[0]=__builtin_amdgcn_mfma_f32_32x32x16_bf16(PAF(2),VFR(2),o[0],0,0,0), C1,0); \
    KRD(GL,3); GAPB(o[1]=__builtin_amdgcn_mfma_f32_32x32x16_bf16(PAF(2),VFR(6),o[1],0,0,0), C1,4); \
    GAPB(o[0]=__builtin_amdgcn_mfma_f32_32x32x16_bf16(PAF(3),VFR(3),o[0],0,0,0), C1,8); \
    GAPB(o[1]=__builtin_amdgcn_mfma_f32_32x32x16_bf16(PAF(3),VFR(7),o[1],0,0,0), C1,12); \
    }while(0)
  int t=1;
  #undef CMASK
  #define CMASK(P0,P1,t) do{}while(0)
  for(;t+5<NT;t+=2){
    STEP(pB0,pB1,pA0,pA1,t,true,true,true);     WAIT_BAR(2); RESC(); ROT();
    STEP(pA0,pA1,pB0,pB1,t+1,true,true,true);   WAIT_BAR(2); RESC(); ROT();
  }
  #undef CMASK
  #define CMASK(P0,P1,t) do{}while(0)
  #define ENDW(tt) do{ if((tt)+3<NT){WAIT_BAR(2);} else if((tt)+2<NT){WAIT_BAR(1);} else {WAIT_BAR(0);} }while(0)
  for(;t+1<NT;t+=2){
    STEP(pB0,pB1,pA0,pA1,t,(t+3<NT),(t+1<NT),(t+1<NT));       ENDW(t);   RESC(); ROT();
    STEP(pA0,pA1,pB0,pB1,t+1,(t+4<NT),(t+2<NT),(t+2<NT));     ENDW(t+1); RESC(); ROT();
  }
  STEP(pB0,pB1,pA0,pA1,NT-1,false,false,false); RESC();
  { float sacc=pB0[0]+pB0[1]; _Pragma("unroll") for(int r=2;r<16;++r)sacc+=pB0[r]; _Pragma("unroll") for(int r=0;r<16;++r)sacc+=pB1[r]; l_reg+=sacc;
    pw0=(u32x4){PKW(pB0,0),PKW(pB0,2),PKW(pB0,4),PKW(pB0,6)};pw1=(u32x4){PKW(pB0,8),PKW(pB0,10),PKW(pB0,12),PKW(pB0,14)};pw2=(u32x4){PKW(pB1,0),PKW(pB1,2),PKW(pB1,4),PKW(pB1,6)};pw3=(u32x4){PKW(pB1,8),PKW(pB1,10),PKW(pB1,12),PKW(pB1,14)};
    SBAR(); pv(o,vb0+sl_cur,PAF(0),PAF(1),PAF(2),PAF(3)); }
  #undef PKW
  #undef PAF
  #undef VFR
  #undef PIN
  #undef MX3
  #undef GAPA
  #undef GAPB
  #undef EX
  #undef VRD
  #undef KRD
  #undef STEP
  #undef ENDW
  {auto rr=__builtin_amdgcn_permlane32_swap(__float_as_uint(l_reg),__float_as_uint(l_reg),false,false);l_reg=__uint_as_float(rr[0])+__uint_as_float(rr[1]);}
  if(hi==0)wsf[32+r32]=l_reg;asm volatile("s_waitcnt lgkmcnt(0)":::"memory");
  float rli[16];
  #pragma unroll
  for(int r=0;r<16;++r)rli[r]=__builtin_amdgcn_rcpf(wsf[32+crow(r,hi)]);
  bf16*Ow=O+(rowbase+q0+wid*QBLK)*OP+h*D;
  { bf16*stg=(bf16*)(shm+LDS_OST)+wid*2048;
    #pragma unroll
    for(int r=0;r<16;++r){const int orow=crow(r,hi);
      #pragma unroll
      for(int d0=0;d0<2;++d0)stg[orow*64+d0*32+r32]=__float2bfloat16(o[d0][r]*rli[r]);}
    asm volatile("s_waitcnt lgkmcnt(0)":::"memory");
    #pragma unroll
    for(int i=0;i<4;++i){const int row=i*8+(lane>>3),ch=lane&7; const u32x4 v=*(const u32x4*)(stg+row*64+ch*8); ATTN_STORE16(Ow+(long)row*OP+ch*8,v);} }
  asm volatile("s_waitcnt lgkmcnt(0)\n\ts_barrier":::"memory");
  #undef DMA_K
  #undef DMA_V
  #undef CMASK
  #undef START
  #undef RESC
  #undef ROT
}
constexpr int ATTN_LDS_BYTES=LDS_BYTES;
template<int THRL=8> __device__ __forceinline__ void attn_phase(char*lds,const bf16*Q,const bf16*K,const bf16*V,bf16*O,int vcu,int G){
  for(int idx=vcu; idx<BATCH*NHEAD*NQB; idx+=G){ const int bh=idx/NQB, qb=idx%NQB; attn_unit<THRL>(bh/NHEAD,bh%NHEAD,qb,Q,K,V,O,lds); }
}
#undef SBAR
#undef WAIT_BAR
}

constexpr int NWAVES = 8;
#ifndef REP_G1
#define REP_G1 1
#endif
#ifndef REP_G3
#define REP_G3 1
#endif
#ifndef REP_P0
#define REP_P0 1
#endif
#ifndef REP_PASS
#define REP_PASS 1
#endif
#ifndef REP_FIN
#define REP_FIN 1
#endif
#ifndef REP_HG1
#define REP_HG1 1
#endif
#ifndef REP_HG2
#define REP_HG2 1
#endif
#ifndef REP_HG3
#define REP_HG3 1
#endif
#ifndef REP_CONV
#define REP_CONV 1
#endif
#ifndef REP_ATTN
#define REP_ATTN 1
#endif
#ifndef MK_SPLIT
#define MK_SPLIT 0
#endif
constexpr int NPHASE = 15;
constexpr size_t MiB = 1u << 20;
constexpr int LDS_BYTES_ = 147456;
constexpr size_t WS_SSQ = 0;
constexpr size_t WS_BAR = 1024 * 1024, BAR_ZERO_BYTES = 16384;
constexpr int MISC_OFF = LDS_BYTES_ - 64;
constexpr size_t WS_ROPE = 512 * 1024;
constexpr size_t WS_W = 2 * MiB, WL_STRIDE = 23 * MiB, WO_IN = 0, WO_OUT = 5 * MiB, WO_1 = 7 * MiB, WO_2 = 15 * MiB;
constexpr size_t WS_XB = 48 * MiB;
constexpr size_t WS_R = 112 * MiB;
constexpr size_t WS_Q = WS_R, WS_K = WS_R + 32 * MiB, WS_V = WS_R + 40 * MiB, WS_ZR = WS_R + 48 * MiB, WS_MIX = WS_R + 160 * MiB, WS_HA = WS_R + 224 * MiB;
constexpr size_t WS_HID = WS_R;
constexpr size_t WS_HS = 368 * MiB, WS_OFW = 400 * MiB, WS_HD = 432 * MiB, WS_END = 433 * MiB;
constexpr size_t WS_OBW = WS_XB;
constexpr int RING_BYTES = 131072, LDS_BYTES = 147456;

#define LAS __attribute__((address_space(3)))
typedef unsigned short bf16;
typedef unsigned v4u __attribute__((ext_vector_type(4)));
typedef unsigned v2u __attribute__((ext_vector_type(2)));
typedef float f32x4 __attribute__((ext_vector_type(4)));
typedef float f32x2_ __attribute__((ext_vector_type(2)));
typedef short bf16x8 __attribute__((ext_vector_type(8)));
#define LDS_WAIT() asm volatile("s_waitcnt lgkmcnt(0)" ::: "memory")
__device__ __forceinline__ unsigned f2bf(float f) { unsigned u = __builtin_bit_cast(unsigned, f); return (u + 0x7fffu + ((u >> 16) & 1u)) >> 16; }
__device__ __forceinline__ unsigned pk2(float lo, float hi) { return f2bf(lo) | (f2bf(hi) << 16); }
typedef __bf16 bf16x2_ __attribute__((ext_vector_type(2)));
__device__ __forceinline__ unsigned cvtpk(float lo, float hi) { f32x2_ v = {lo, hi}; bf16x2_ b = __builtin_convertvector(v, bf16x2_); return __builtin_bit_cast(unsigned, b); }
__device__ __forceinline__ float bf2f(unsigned h) { return __uint_as_float(h << 16); }
__device__ __forceinline__ float sigmoidf_(float x) { return __builtin_amdgcn_rcpf(1.f + __builtin_amdgcn_exp2f(fmaxf(x, -60.f) * -1.4426950408889634f)); }
__device__ __forceinline__ float wave_sum(float v) {
#pragma unroll
    for (int o = 1; o < 64; o <<= 1) v += __shfl_xor(v, o);
    return v;
}

#define XB_TMO      128
#define XB_XCNT(j)  (256  + 64 * (j))
#define XB_XSUB(j)  (1280 + 64 * (j))
#define XB_XGEN(j)  (2304 + 64 * (j))
#define XB_TOP      3328
#define XB_TOPGEN   3392
#define XCD_BAR_WORDS 3456
#define XB_SPIN_CAP (1u << 18)

__device__ __forceinline__ unsigned xb_ld(unsigned* p)              { return __hip_atomic_load(p, __ATOMIC_RELAXED, __HIP_MEMORY_SCOPE_AGENT); }
__device__ __forceinline__ unsigned xb_add(unsigned* p, unsigned v) { return __hip_atomic_fetch_add(p, v, __ATOMIC_RELAXED, __HIP_MEMORY_SCOPE_AGENT); }
__device__ __forceinline__ unsigned xb_xcc_id() { return (unsigned)__builtin_amdgcn_s_getreg((3 << 11) | 20) & 0xFu; }
#define XB_SPIN(cond, bar) do { unsigned _sp = 0; while (cond) { __builtin_amdgcn_s_sleep(1); \
    if ((++_sp & 255u) == 0u) { if (xb_ld(&(bar)[XB_TMO])) break; if (_sp > XB_SPIN_CAP) { atomicAdd(&(bar)[XB_TMO], 1u); break; } } } } while (0)

struct XcdBarrier {
    unsigned* bar; unsigned x;
    volatile LAS unsigned* st;
};

__device__ __forceinline__ XcdBarrier xcd_barrier_post(unsigned* bar, volatile LAS unsigned* st) {
    XcdBarrier b; b.bar = bar; b.x = xb_xcc_id(); b.st = st;
    if (threadIdx.x == 0) (void)xb_add(&bar[XB_XCNT(b.x)], 1u);
    return b;
}
__device__ __forceinline__ void xcd_barrier_complete(unsigned* bar, unsigned x, unsigned& nloc, unsigned& nx) {
    const unsigned G = gridDim.x * gridDim.y * gridDim.z;
    unsigned sum, cnt, mine, sp = 0u;
    for (;;) {
        sum = 0u; cnt = 0u; mine = 0u;
#pragma unroll
        for (unsigned j = 0; j < 16; ++j) { const unsigned c = xb_ld(&bar[XB_XCNT(j)]); sum += c; cnt += (c > 0u) ? 1u : 0u; mine = (j == x) ? c : mine; }
        if (sum == G) break;
        __builtin_amdgcn_s_sleep(1);
        if ((++sp & 255u) == 0u) { if (xb_ld(&bar[XB_TMO])) break; if (sp > XB_SPIN_CAP) { atomicAdd(&bar[XB_TMO], 1u); break; } }
    }
    nloc = mine > 0u ? mine : 1u; nx = cnt > 0u ? cnt : 1u;
}

__device__ __forceinline__ void xcd_barrier(const XcdBarrier& b) {
    asm volatile("s_waitcnt vmcnt(0)" ::: "memory");
    __syncthreads();
    if (threadIdx.x == 0) {
        unsigned* bar = b.bar;
        __builtin_amdgcn_s_waitcnt(0);
        unsigned nloc = b.st[0], nx = b.st[1];
        if (nloc == 0u) { xcd_barrier_complete(bar, b.x, nloc, nx); b.st[0] = nloc; b.st[1] = nx; }
        const unsigned old = xb_add(&bar[XB_XSUB(b.x)], 1u);
        const unsigned gen = old / nloc;
        if (old + 1u == (gen + 1u) * nloc) {
            __builtin_amdgcn_fence(__ATOMIC_RELEASE, "agent");
            asm volatile("s_waitcnt vmcnt(0)" ::: "memory");
            const unsigned og = xb_add(&bar[XB_TOP], 1u);
            const unsigned tg = og / nx;
            if (og + 1u == (tg + 1u) * nx) xb_add(&bar[XB_TOPGEN], 1u);
            else XB_SPIN(xb_ld(&bar[XB_TOPGEN]) == tg, bar);
            __builtin_amdgcn_fence(__ATOMIC_ACQUIRE, "agent");
            xb_add(&bar[XB_XGEN(b.x)], 1u);
            asm volatile("s_waitcnt vmcnt(0)" ::: "memory");
        } else {
            XB_SPIN(xb_ld(&bar[XB_XGEN(b.x)]) == gen, bar);
            __builtin_amdgcn_fence(__ATOMIC_ACQUIRE, "agent");
            asm volatile("s_waitcnt vmcnt(0)" ::: "memory");
        }
    }
    __syncthreads();
}

struct Params {
    const float *x, *w_in, *w_out, *norm_mix, *norm_mlp, *q_norm, *k_norm, *lb_fwd, *lb_bwd, *hgrn_norm, *conv_w, *conv_b, *conv_ln_g, *conv_ln_b, *w_mlp_in, *w_mlp_out;
    float* out; unsigned char* ws; int ph_lo, ph_hi;
};
typedef const __attribute__((address_space(4))) Params* KP;
struct Frame { LAS unsigned char* lds; int tid, lane, wave, vcu, G; };
__device__ __forceinline__ Frame mkframe(LAS unsigned char* lds) {
    Frame F; int t = threadIdx.x; asm volatile("" : "+v"(t));
    F.lds = lds; F.tid = t; F.lane = t & 63; F.wave = __builtin_amdgcn_readfirstlane(t >> 6);
    F.G = gridDim.x; { const int bx = blockIdx.x; F.vcu = (F.G % 8 == 0) ? (bx % 8) * (F.G / 8) + bx / 8 : bx; }
    return F;
}

__device__ __forceinline__ int phys_row(int n, int mode) {
    if (mode == 1 && n < 768) { const int w = n & 255, hh = w >> 6, d = w & 63; return (n & ~255) + 128 * (d >> 5) + 32 * hh + (d & 31); }
    const int l = n & 31; return (n & ~31) + 16 * ((l >> 2) & 1) + 4 * (l >> 3) + (l & 3);
}
__device__ __forceinline__ void p0_item(const float* W, const float* g, int K, int N, bf16* WT, int mode, LAS float* scr, int item, int lane) {
    const int nblk = N / 32, kb = item / nblk, nb = item % nblk, k0 = 64 * kb, n0 = 32 * nb;
    float wv[32];
#pragma unroll
    for (int i = 0; i < 32; ++i) { const int kk = 2 * i + (lane >> 5); wv[i] = W[(size_t)(k0 + kk) * N + n0 + (lane & 31)] * (g ? g[k0 + kk] : 1.f); }
#pragma unroll
    for (int i = 0; i < 32; ++i) { const int kk = 2 * i + (lane >> 5); scr[kk * 33 + (lane & 31)] = wv[i]; }
    LDS_WAIT(); asm volatile("" ::: "memory");
    const int c = lane & 7;
#pragma unroll
    for (int j = 0; j < 4; ++j) { const int n = (lane >> 3) + 8 * j; const LAS float* s = scr + (8 * c) * 33 + n;
        v4u o; o.x = pk2(s[0 * 33], s[1 * 33]); o.y = pk2(s[2 * 33], s[3 * 33]); o.z = pk2(s[4 * 33], s[5 * 33]); o.w = pk2(s[6 * 33], s[7 * 33]);
        *(v4u*)(WT + (size_t)phys_row(n0 + n, mode) * K + k0 + 8 * c) = o; }
    LDS_WAIT(); asm volatile("" ::: "memory");
}
constexpr int I_IN = (DMODEL / 64) * (INCOLS / 32), I_OUT = (DMODEL / 64) * (DMODEL / 32), I_1 = (DMODEL / 64) * (DFF / 32), I_2 = (DFF / 64) * (DMODEL / 32), I_L = I_IN + I_OUT + I_1 + I_2;
__device__ __forceinline__ void p0_weights(const Frame& F, KP P, LAS float* scr, int first, int last) {
    const int gw = F.vcu * NWAVES + F.wave, NGW = F.G * NWAVES;
    for (int it = first + gw; it < last; it += NGW) {
        const int l = it / I_L; int r = it % I_L; bf16* wb = (bf16*)(P->ws + WS_W + (size_t)l * WL_STRIDE);
        if (r < I_IN) { p0_item(P->w_in + (size_t)l * DMODEL * INCOLS, P->norm_mix + l * DMODEL, DMODEL, INCOLS, (bf16*)((unsigned char*)wb + WO_IN), 1, scr, r, F.lane); continue; } r -= I_IN;
        if (r < I_OUT) { p0_item(P->w_out + (size_t)l * DMODEL * DMODEL, nullptr, DMODEL, DMODEL, (bf16*)((unsigned char*)wb + WO_OUT), 0, scr, r, F.lane); continue; } r -= I_OUT;
        if (r < I_1) { p0_item(P->w_mlp_in + (size_t)l * DMODEL * DFF, P->norm_mlp + l * DMODEL, DMODEL, DFF, (bf16*)((unsigned char*)wb + WO_1), 0, scr, r, F.lane); continue; } r -= I_1;
        p0_item(P->w_mlp_out + (size_t)l * DFF * DMODEL, nullptr, DFF, DMODEL, (bf16*)((unsigned char*)wb + WO_2), 0, scr, r, F.lane);
    }
}
__device__ __forceinline__ void p0_prologue(const Frame& F, KP P) {
    const int gw = F.vcu * NWAVES + F.wave, NGW = F.G * NWAVES;
    p0_weights(F, P, (LAS float*)(F.lds + F.wave * 16384), 0, I_IN);
    float* ssq = (float*)(P->ws + WS_SSQ); bf16* XB = (bf16*)(P->ws + WS_XB);
    for (int m0 = gw * 4; m0 < TOK; m0 += NGW * 4) {
        f32x4 v[4][4]; float sq[4];
#pragma unroll
        for (int i = 0; i < 4; ++i) { const f32x4* xr = (const f32x4*)(P->x + (size_t)(m0 + i) * DMODEL) + F.lane;
#pragma unroll
            for (int j = 0; j < 4; ++j) v[i][j] = xr[64 * j]; }
#pragma unroll
        for (int i = 0; i < 4; ++i) { float s = 0.f;
#pragma unroll
            for (int j = 0; j < 4; ++j) s += (v[i][j].x * v[i][j].x + v[i][j].y * v[i][j].y) + (v[i][j].z * v[i][j].z + v[i][j].w * v[i][j].w);
            sq[i] = wave_sum(s);
            v2u* o8 = (v2u*)(XB + (size_t)(m0 + i) * DMODEL) + F.lane;
#pragma unroll
            for (int j = 0; j < 4; ++j) { v2u w; w.x = cvtpk(v[i][j].x, v[i][j].y); w.y = cvtpk(v[i][j].z, v[i][j].w); o8[64 * j] = w; } }
        if (F.lane < 4) ssq[m0 + F.lane] = F.lane == 0 ? sq[0] : F.lane == 1 ? sq[1] : F.lane == 2 ? sq[2] : sq[3];
    }
    const int gt = F.vcu * (NWAVES * 64) + F.tid, NGT = F.G * NWAVES * 64;
    for (int i = gt; i < 3 * TOK; i += NGT) ssq[TOK + i] = 0.f;
    float* rc = (float*)(P->ws + WS_ROPE); float* rs = rc + 256 * 16;
    for (int i = gt; i < 256 * 16; i += NGT) { const int pos = i >> 4, k = i & 15;
        const float invf = (float)pow(10000.0, -(double)k / 16.0); const float ang = (float)pos * invf;
        rc[i] = (float)cos((double)ang); rs[i] = (float)sin((double)ang); }
}

constexpr int HG_QB = 0, HG_KB = 4352, HG_KBT = 8704, HG_VT = 12800, HG_DEC = 16896, HG_WAVE_BYTES = 17152;
template <bool FULL>
__device__ __forceinline__ float hg_prep(LAS unsigned char* w, const bf16* zbase, int tok0, int step, int dir, float lb, int lane) {
    float E = 1.f; unsigned kbt[16], vtp[16]; const float oml = 1.f - lb;
#pragma unroll
    for (int tp = 0; tp < 16; ++tp) {
        float kb[2], qe[2]; unsigned vr[2];
#pragma unroll
        for (int u = 0; u < 2; ++u) {
            const bf16* zr = zbase + (size_t)(tok0 + step * (2 * tp + u)) * ZRP + lane;
            const float zf = fmaxf(bf2f(zr[512 + 256 * dir]), -60.f); vr[u] = zr[256];
            const float e = __builtin_amdgcn_exp2f(zf * -1.4426950408889634f), s = __builtin_amdgcn_rcpf(1.f + e);
            const float f = lb + oml * s, kk = oml * e * s;
            E *= f;
            kb[u] = kk * __builtin_amdgcn_rcpf(fmaxf(E, 1e-30f));
            if (FULL) qe[u] = bf2f(zr[0]) * E;
        }
        kbt[tp] = cvtpk(kb[0], kb[1]); vtp[tp] = vr[0] | (vr[1] << 16);
        if (FULL) { const unsigned qp = cvtpk(qe[0], qe[1]);
            ((LAS bf16*)(w + HG_QB))[(2 * tp) * 68 + lane] = (bf16)qp; ((LAS bf16*)(w + HG_QB))[(2 * tp + 1) * 68 + lane] = (bf16)(qp >> 16);
            ((LAS bf16*)(w + HG_KB))[(2 * tp) * 68 + lane] = (bf16)kbt[tp]; ((LAS bf16*)(w + HG_KB))[(2 * tp + 1) * 68 + lane] = (bf16)(kbt[tp] >> 16); }
        if ((tp & 7) == 7) asm volatile("" ::: "memory");
    }
#pragma unroll
    for (int i = 0; i < 4; ++i) {
        *(LAS v4u*)(w + HG_KBT + lane * 64 + 16 * i) = (v4u){kbt[4 * i], kbt[4 * i + 1], kbt[4 * i + 2], kbt[4 * i + 3]};
        *(LAS v4u*)(w + HG_VT + lane * 64 + 16 * i) = (v4u){vtp[4 * i], vtp[4 * i + 1], vtp[4 * i + 2], vtp[4 * i + 3]}; }
    ((LAS float*)(w + HG_DEC))[lane] = E;
    return E;
}
__device__ __forceinline__ void hg_update(f32x4 (&S)[4][4], LAS unsigned char* w, int r, int q) {
    bf16x8 a[4], bv[4];
#pragma unroll
    for (int t = 0; t < 4; ++t) { a[t] = *(const LAS bf16x8*)(w + HG_KBT + (16 * t + r) * 64 + 16 * q); bv[t] = *(const LAS bf16x8*)(w + HG_VT + (16 * t + r) * 64 + 16 * q); }
#pragma unroll
    for (int kt = 0; kt < 4; ++kt) { const f32x4 d = *(const LAS f32x4*)(w + HG_DEC + (16 * kt + 4 * q) * 4);
#pragma unroll
        for (int vt = 0; vt < 4; ++vt) { S[kt][vt] = __builtin_amdgcn_mfma_f32_16x16x32_bf16(a[kt], bv[vt], S[kt][vt], 0, 0, 0); S[kt][vt] *= d; } }
}
__device__ __forceinline__ float hg_lb(const float* lbp, int layer, int ch) { return layer == 0 ? 0.f : sigmoidf_(lbp[256 + ch] - lbp[ch]); }

__device__ __forceinline__ void hg_local(const Frame& F, KP P, int layer) {
    LAS unsigned char* w = F.lds + F.wave * HG_WAVE_BYTES; const int lane = F.lane, r = lane & 15, q = lane >> 4, dir = F.wave & 1;
    const bf16* ZR = (const bf16*)(P->ws + WS_ZR); float* HA = (float*)(P->ws + WS_HA); float* HD = (float*)(P->ws + WS_HD);
    for (int it = F.vcu * 4 + (F.wave >> 1); it < 1024; it += F.G * 4) {
        const int bh = it >> 7, blk = it & 127, b = bh >> 2, h = bh & 3;
        const bf16* zbase = ZR + (size_t)b * SEQL * ZRP + 64 * h;
        const float lb = hg_lb(dir ? P->lb_bwd : P->lb_fwd, layer, 64 * h + lane);
        f32x4 S[4][4];
#pragma unroll
        for (int a = 0; a < 4; ++a)
#pragma unroll
            for (int c = 0; c < 4; ++c) S[a][c] = (f32x4){0.f, 0.f, 0.f, 0.f};
        float etot = 1.f;
#pragma unroll 1
        for (int cn = 0; cn < 4; ++cn) {
            const int tok0 = dir ? blk * 128 + 127 - 32 * cn : blk * 128 + 32 * cn;
            etot *= hg_prep<false>(w, zbase, tok0, dir ? -1 : 1, dir, lb, lane);
            LDS_WAIT(); __builtin_amdgcn_wave_barrier();
            hg_update(S, w, r, q);
            LDS_WAIT(); __builtin_amdgcn_wave_barrier();
        }
        float* ha = HA + (size_t)(it * 2 + dir) * 4096;
#pragma unroll
        for (int kt = 0; kt < 4; ++kt)
#pragma unroll
            for (int vt = 0; vt < 4; ++vt)
#pragma unroll
                for (int e = 0; e < 4; ++e) ha[(16 * kt + 4 * q + e) * 64 + 16 * vt + r] = S[kt][vt][e];
        HD[(it * 2 + dir) * 64 + lane] = etot;
    }
}
__device__ __forceinline__ void hg_scan(const Frame& F, KP P) {
    if (F.tid >= 256) return;
    const float* HA = (const float*)(P->ws + WS_HA); const float* HD = (const float*)(P->ws + WS_HD); float* HS = (float*)(P->ws + WS_HS);
    for (int idx = F.vcu * 256 + F.tid; idx < 16 * 4096; idx += F.G * 256) {
        const int bh = idx >> 13, dir = (idx >> 12) & 1, e = idx & 4095, k = e >> 6;
        float S = 0.f;
#pragma unroll 1
        for (int s0 = 0; s0 < 128; s0 += 32) {
            float a[32], d[32];
#pragma unroll
            for (int j = 0; j < 32; ++j) { const int blk = dir ? 127 - (s0 + j) : s0 + j; const size_t it2 = (size_t)((bh * 128 + blk) * 2 + dir); a[j] = HA[it2 * 4096 + e]; d[j] = HD[it2 * 64 + k]; }
#pragma unroll
            for (int j = 0; j < 32; ++j) { const int blk = dir ? 127 - (s0 + j) : s0 + j; const size_t it2 = (size_t)((bh * 128 + blk) * 2 + dir); HS[it2 * 4096 + e] = S; S = d[j] * S + a[j]; }
        }
    }
}
__device__ __forceinline__ void hg_out(const Frame& F, KP P, int layer) {
    LAS unsigned char* w = F.lds + F.wave * HG_WAVE_BYTES; const int lane0 = F.lane, dir = F.wave & 1;
    const bf16* ZR = (const bf16*)(P->ws + WS_ZR); const float* HS = (const float*)(P->ws + WS_HS); bf16* MIX = (bf16*)(P->ws + WS_MIX);
    bf16* OFW = (bf16*)(P->ws + WS_OFW); bf16* OBW = (bf16*)(P->ws + WS_OBW); bf16* OD = dir ? OBW : OFW;
    for (int base = F.vcu * 4; base < 1024; base += F.G * 4) {
        const int it = base + (F.wave >> 1);
        const int bh = it >> 7, blk = it & 127, b = bh >> 2, h = bh & 3;
        const bf16* zbase = ZR + (size_t)b * SEQL * ZRP + 64 * h;
#pragma unroll 1
        for (int rp_ = 0; rp_ < REP_PASS; ++rp_) {
            int lane = lane0; asm volatile("" : "+v"(lane)); const int r = lane & 15, q = lane >> 4;
            const float lb = hg_lb(dir ? P->lb_bwd : P->lb_fwd, layer, 64 * h + lane);
            f32x4 S[4][4];
            { const float* hs = HS + (size_t)(it * 2 + dir) * 4096;
#pragma unroll
              for (int kt = 0; kt < 4; ++kt)
#pragma unroll
                for (int vt = 0; vt < 4; ++vt)
#pragma unroll
                    for (int e = 0; e < 4; ++e) S[kt][vt][e] = hs[(16 * kt + 4 * q + e) * 64 + 16 * vt + r]; }
#pragma unroll 1
            for (int cn = 0; cn < 4; ++cn) {
                const int step = dir ? -1 : 1, tok0 = dir ? blk * 128 + 127 - 32 * cn : blk * 128 + 32 * cn;
                (void)hg_prep<true>(w, zbase, tok0, step, dir, lb, lane);
                LDS_WAIT(); __builtin_amdgcn_wave_barrier();
                bf16x8 qf[2][2], kf[2][2];
#pragma unroll
                for (int t = 0; t < 2; ++t)
#pragma unroll
                    for (int ks = 0; ks < 2; ++ks) {
                        const v2u q0 = *(const LAS v2u*)(w + HG_QB + (16 * t + r) * 136 + 64 * ks + 8 * q), q1 = *(const LAS v2u*)(w + HG_QB + (16 * t + r) * 136 + 64 * ks + 8 * q + 32);
                        const v2u k0 = *(const LAS v2u*)(w + HG_KB + (16 * t + r) * 136 + 64 * ks + 8 * q), k1 = *(const LAS v2u*)(w + HG_KB + (16 * t + r) * 136 + 64 * ks + 8 * q + 32);
                        qf[t][ks] = __builtin_bit_cast(bf16x8, (v4u){q0.x, q0.y, q1.x, q1.y}); kf[t][ks] = __builtin_bit_cast(bf16x8, (v4u){k0.x, k0.y, k1.x, k1.y}); }
                const f32x4 z4 = (f32x4){0.f, 0.f, 0.f, 0.f};
                f32x4 p00 = z4, p01 = z4, p11 = z4;
#pragma unroll
                for (int ks = 0; ks < 2; ++ks) { p00 = __builtin_amdgcn_mfma_f32_16x16x32_bf16(kf[0][ks], qf[0][ks], p00, 0, 0, 0);
                    p01 = __builtin_amdgcn_mfma_f32_16x16x32_bf16(kf[0][ks], qf[1][ks], p01, 0, 0, 0); p11 = __builtin_amdgcn_mfma_f32_16x16x32_bf16(kf[1][ks], qf[1][ks], p11, 0, 0, 0); }
#pragma unroll
                for (int e = 0; e < 4; ++e) { if (4 * q + e > r) { p00[e] = 0.f; p11[e] = 0.f; } }
                bf16x8 pa[2];
                pa[0] = __builtin_bit_cast(bf16x8, (v4u){cvtpk(p00[0], p00[1]), cvtpk(p00[2], p00[3]), 0u, 0u});
                pa[1] = __builtin_bit_cast(bf16x8, (v4u){cvtpk(p01[0], p01[1]), cvtpk(p01[2], p01[3]), cvtpk(p11[0], p11[1]), cvtpk(p11[2], p11[3])});
                f32x4 o[2][4];
#pragma unroll
                for (int vt = 0; vt < 4; ++vt) {
                    const v2u v0 = *(const LAS v2u*)(w + HG_VT + (16 * vt + r) * 64 + 8 * q), v1 = *(const LAS v2u*)(w + HG_VT + (16 * vt + r) * 64 + 8 * q + 32);
                    const bf16x8 vf = __builtin_bit_cast(bf16x8, (v4u){v0.x, v0.y, v1.x, v1.y});
#pragma unroll
                    for (int t = 0; t < 2; ++t) o[t][vt] = __builtin_amdgcn_mfma_f32_16x16x32_bf16(pa[t], vf, z4, 0, 0, 0);
#pragma unroll
                    for (int ks = 0; ks < 2; ++ks) {
                        const f32x4 s0 = S[2 * ks][vt], s1 = S[2 * ks + 1][vt];
                        const bf16x8 sb = __builtin_bit_cast(bf16x8, (v4u){cvtpk(s0[0], s0[1]), cvtpk(s0[2], s0[3]), cvtpk(s1[0], s1[1]), cvtpk(s1[2], s1[3])});
#pragma unroll
                        for (int t = 0; t < 2; ++t) o[t][vt] = __builtin_amdgcn_mfma_f32_16x16x32_bf16(qf[t][ks], sb, o[t][vt], 0, 0, 0);
                    }
                }
                hg_update(S, w, r, q);
#pragma unroll
                for (int t = 0; t < 2; ++t)
#pragma unroll
                    for (int e = 0; e < 4; ++e)
#pragma unroll
                        for (int vt = 0; vt < 4; ++vt) ((LAS bf16*)(w + HG_QB))[(16 * t + 4 * q + e) * 68 + 16 * vt + r] = (bf16)cvtpk(o[t][vt][e], 0.f);
                LDS_WAIT(); __builtin_amdgcn_wave_barrier();
#pragma unroll
                for (int k = 0; k < 4; ++k) {
                    const int ci = k * 64 + lane, row = ci >> 3, c16 = ci & 7;
                    const v2u lo = *(const LAS v2u*)(w + HG_QB + row * 136 + c16 * 16), hi = *(const LAS v2u*)(w + HG_QB + row * 136 + c16 * 16 + 8);
                    *(v4u*)(OD + ((size_t)b * SEQL + (tok0 + step * row)) * 256 + 64 * h + c16 * 8) = (v4u){lo.x, lo.y, hi.x, hi.y};
                }
                LDS_WAIT(); __builtin_amdgcn_wave_barrier();
            }
        }
        asm volatile("s_waitcnt vmcnt(0)" ::: "memory");
        __syncthreads();
#pragma unroll 1
        for (int rf_ = 0; rf_ < REP_FIN; ++rf_) {
            const int tl = lane0 >> 3, vc = (lane0 & 7) * 8;
            const f32x4 g0 = *(const f32x4*)(P->hgrn_norm + layer * 256 + 64 * h + vc), g1 = *(const f32x4*)(P->hgrn_norm + layer * 256 + 64 * h + vc + 4);
            const size_t row0 = (size_t)b * SEQL + blk * 128 + 64 * dir + tl;
            v4u of[8], ob[8], gz[8];
#pragma unroll
            for (int j = 0; j < 8; ++j) { const size_t row = row0 + 8 * j;
                of[j] = *(const v4u*)(OFW + row * 256 + 64 * h + vc); ob[j] = *(const v4u*)(OBW + row * 256 + 64 * h + vc);
                gz[j] = *(const v4u*)(ZR + row * ZRP + 1024 + 64 * h + vc); }
#pragma unroll
            for (int j = 0; j < 8; ++j) { const size_t row = row0 + 8 * j;
                float t[8]; float ss = 0.f;
#pragma unroll
                for (int i = 0; i < 4; ++i) { t[2 * i] = bf2f(of[j][i] & 0xffffu) + bf2f(ob[j][i] & 0xffffu); t[2 * i + 1] = bf2f(of[j][i] >> 16) + bf2f(ob[j][i] >> 16); ss += t[2 * i] * t[2 * i] + t[2 * i + 1] * t[2 * i + 1]; }
                ss += __shfl_xor(ss, 1); ss += __shfl_xor(ss, 2); ss += __shfl_xor(ss, 4);
                const float rn = rsqrtf(ss * (1.f / 64.f) + EPS);
                unsigned ow[4];
#pragma unroll
                for (int i = 0; i < 4; ++i) { const float ga = bf2f(gz[j][i] & 0xffffu), gb = bf2f(gz[j][i] >> 16);
                    const float na = (2 * i < 4) ? g0[2 * i] : g1[2 * i - 4], nb = (2 * i + 1 < 4) ? g0[2 * i + 1] : g1[2 * i + 1 - 4];
                    ow[i] = cvtpk(t[2 * i] * rn * na * (ga * sigmoidf_(ga)), t[2 * i + 1] * rn * nb * (gb * sigmoidf_(gb))); }
                *(v4u*)(MIX + row * 1024 + 512 + 64 * h + vc) = (v4u){ow[0], ow[1], ow[2], ow[3]}; }
        }
        __syncthreads();
    }
}

__device__ __forceinline__ void conv_load(unsigned (&av)[16], unsigned (&gv)[16], const bf16* ZR, int item, int tid) {
    const int b = item >> 9, t0 = (item & 511) * 32, c2 = (tid & 127) * 2, r0 = tid >> 7;
#pragma unroll
    for (int k = 0; k < 16; ++k) { int t = t0 - 15 + r0 + 4 * k; t = t < 0 ? 0 : (t > SEQL - 1 ? SEQL - 1 : t);
        const bf16* zr = ZR + ((size_t)b * SEQL + t) * ZRP; av[k] = *(const unsigned*)(zr + 1280 + c2); gv[k] = *(const unsigned*)(zr + 1536 + c2); }
}
__device__ __forceinline__ void conv_phase(const Frame& F, KP P, int layer) {
    LAS float* U = (LAS float*)F.lds;
    LAS float* Y = U + 62 * 256;
    const bf16* ZR = (const bf16*)(P->ws + WS_ZR); bf16* MIX = (bf16*)(P->ws + WS_MIX);
    const float* cw = P->conv_w + layer * 31 * 256;
    const int c = F.tid & 255, half = F.tid >> 8;
    float wgt[31];
#pragma unroll
    for (int j = 0; j < 31; ++j) wgt[j] = cw[j * 256 + c];
    const float bias = P->conv_b[layer * 256 + c];
    const f32x4 g4 = *(const f32x4*)(P->conv_ln_g + layer * 256 + 4 * F.lane), b4 = *(const f32x4*)(P->conv_ln_b + layer * 256 + 4 * F.lane);
    unsigned av[16], gv[16];
    conv_load(av, gv, ZR, F.vcu < 1024 ? F.vcu : 1023, F.tid);
    for (int item = F.vcu; item < 1024; item += F.G) {
        const int b = item >> 9, t0 = (item & 511) * 32;
        {   const int c2 = (F.tid & 127) * 2, r0 = F.tid >> 7;
#pragma unroll
            for (int k = 0; k < 16; ++k) { const int rr = r0 + 4 * k;
                const int t = t0 - 15 + rr; const bool ok = (t >= 0 && t < SEQL);
                float u0 = bf2f(av[k] & 0xffffu) * sigmoidf_(bf2f(gv[k] & 0xffffu)), u1 = bf2f(av[k] >> 16) * sigmoidf_(bf2f(gv[k] >> 16)); u0 = ok ? u0 : 0.f; u1 = ok ? u1 : 0.f;
                if (rr < 62) *(LAS f32x2_*)(U + rr * 256 + c2) = (f32x2_){u0, u1}; }
        }
        __syncthreads();
        conv_load(av, gv, ZR, item + F.G < 1024 ? item + F.G : 1023, F.tid);
        {
            const LAS float* up = U + (half * 16) * 256 + c; float acc[16];
#pragma unroll
            for (int t = 0; t < 16; ++t) acc[t] = bias;
#pragma unroll
            for (int i = 0; i < 46; ++i) { const float uv = up[i * 256];
#pragma unroll
                for (int t = 0; t < 16; ++t) { if (i - t >= 0 && i - t < 31) acc[t] += wgt[i - t] * uv; } }
#pragma unroll
            for (int t = 0; t < 16; ++t) Y[(half * 16 + t) * 256 + c] = acc[t];
        }
        __syncthreads();
#pragma unroll
        for (int tt = 0; tt < 4; ++tt) { const int tk = F.wave * 4 + tt;
            const f32x4 y = *(const LAS f32x4*)(Y + tk * 256 + 4 * F.lane);
            const float mean = wave_sum((y[0] + y[1]) + (y[2] + y[3])) * (1.f / 256.f);
            const f32x4 d = y - mean; const float var = wave_sum(pg8::dot4(d)) * (1.f / 256.f);
            f32x4 o = d * rsqrtf(var + EPS) * g4 + b4;
#pragma unroll
            for (int j = 0; j < 4; ++j) o[j] = o[j] * sigmoidf_(o[j]);
            v2u wv; wv.x = cvtpk(o[0], o[1]); wv.y = cvtpk(o[2], o[3]);
            *(v2u*)(MIX + ((size_t)b * SEQL + t0 + tk) * 1024 + 768 + 4 * F.lane) = wv; }
        __syncthreads();
    }
}

__global__ void __launch_bounds__(NWAVES * 64, 2) fwd_kernel(Params Pk) {
    extern __shared__ __attribute__((aligned(16))) unsigned char lds[];
    cg::grid_group grid = cg::this_grid();
    const int lo = Pk.ph_lo, hi = Pk.ph_hi;
    if (threadIdx.x < 16) ((LAS unsigned*)((LAS unsigned char*)lds + MISC_OFF))[threadIdx.x] = 0u;
    __syncthreads();
    XcdBarrier xbar; xbar.bar = (unsigned*)(Pk.ws + WS_BAR); xbar.x = 0; xbar.st = nullptr;
    if (hi - lo > 1) xbar = xcd_barrier_post((unsigned*)(Pk.ws + WS_BAR), (volatile LAS unsigned*)((LAS unsigned char*)lds + MISC_OFF));
#define IN(k) (lo <= (k) && (k) < hi)
#define SEAM(k) do { if (IN(k) && IN((k) + 1)) xcd_barrier(xbar); } while (0)
    if (lo < 0) grid.sync();
#define FRESH() const Frame F = mkframe((LAS unsigned char*)lds); KP P = (KP)__builtin_amdgcn_kernarg_segment_ptr(); asm volatile("" : "+s"(P)); unsigned char* const ws = P->ws; (void)ws; (void)F

#ifndef NO_P0
    if (IN(0)) for (int rep_ = 0; rep_ < REP_P0; ++rep_) { FRESH(); p0_prologue(F, P); __syncthreads(); }
#endif
    SEAM(0);
#pragma unroll 1
    for (int l = 0; l < 2; ++l) {
        const int pb = 1 + 7 * l;
#ifndef NO_G1
        if (IN(pb)) for (int rep_ = 0; rep_ < REP_G1; ++rep_) {
            FRESH(); float* ssq = (float*)(ws + WS_SSQ); const float* ropec = (const float*)(ws + WS_ROPE);
            pg8::Gemm g{(const bf16*)(ws + WS_XB), (const bf16*)(ws + WS_W + (size_t)l * WL_STRIDE + WO_IN), TOK, INCOLS, DMODEL}; pg8::StaticOrder S; S.init(TOK, INCOLS, F.G, (int)blockIdx.x);
            pg8::EpiInProj E{ssq + (size_t)(2 * l) * TOK, (bf16*)(ws + WS_Q), (bf16*)(ws + WS_K), (bf16*)(ws + WS_V), (bf16*)(ws + WS_ZR), P->q_norm + l * 64, P->k_norm + l * 64, ropec, ropec + 256 * 16};
            pg8::gemm_phase<pg8::EpiInProj, pg8::StaticOrder, PG8_ALIGN, PG8_SP2>(F.lds, g, S, E);
        }
#endif
        SEAM(pb);
#ifndef NO_HG1
        if (IN(pb + 1)) { for (int rep_ = 0; rep_ < REP_HG1; ++rep_) { FRESH(); hg_local(F, P, l); }
            if (l == 0) { FRESH(); p0_weights(F, P, (LAS float*)(F.lds + F.wave * HG_WAVE_BYTES), I_IN, I_L); } }
#endif
        SEAM(pb + 1);
#ifndef NO_HG2
        if (IN(pb + 2)) { for (int rep_ = 0; rep_ < REP_HG2; ++rep_) { FRESH(); hg_scan(F, P); }
            if (l == 0) { FRESH(); p0_weights(F, P, (LAS float*)(F.lds + F.wave * HG_WAVE_BYTES), I_L, 2 * I_L); } }
#endif
        SEAM(pb + 2);
        if (IN(pb + 3)) {
#ifndef NO_HG3
            for (int rep_ = 0; rep_ < REP_HG3; ++rep_) { FRESH(); hg_out(F, P, l); }
#endif
            __syncthreads();
#ifndef NO_CONV
            for (int rep_ = 0; rep_ < REP_CONV; ++rep_) { FRESH(); conv_phase(F, P, l); }
#endif
            __syncthreads();
#ifndef NO_ATTN
            for (int rep_ = 0; rep_ < REP_ATTN; ++rep_) { FRESH(); attn_body::attn_phase<8>((char*)lds, (const attn_body::bf16*)(ws + WS_Q), (const attn_body::bf16*)(ws + WS_K), (const attn_body::bf16*)(ws + WS_V), (attn_body::bf16*)(ws + WS_MIX), F.vcu, F.G); }
#endif
        }
        SEAM(pb + 3);
#ifndef NO_G2
        if (IN(pb + 4)) {
            FRESH(); float* ssq = (float*)(ws + WS_SSQ);
            pg8::Gemm g{(const bf16*)(ws + WS_MIX), (const bf16*)(ws + WS_W + (size_t)l * WL_STRIDE + WO_OUT), TOK, DMODEL, DMODEL}; pg8::StaticOrder S; S.init(TOK, DMODEL, F.G, (int)blockIdx.x);
            pg8::EpiResid E{l == 0 ? P->x : (const float*)P->out, P->out, (bf16*)(ws + WS_XB), ssq + (size_t)(2 * l + 1) * TOK};
            pg8::gemm_phase<pg8::EpiResid, pg8::StaticOrder, PG8_ALIGN, PG8_SP2>(F.lds, g, S, E);
        }
#endif
        SEAM(pb + 4);
#ifndef NO_G3
        if (IN(pb + 5)) for (int rep_ = 0; rep_ < REP_G3; ++rep_) {
            FRESH(); float* ssq = (float*)(ws + WS_SSQ);
            pg8::Gemm g{(const bf16*)(ws + WS_XB), (const bf16*)(ws + WS_W + (size_t)l * WL_STRIDE + WO_1), TOK, DFF, DMODEL}; pg8::StaticOrder S; S.init(TOK, DFF, F.G, (int)blockIdx.x);
            pg8::EpiMlpIn E{ssq + (size_t)(2 * l + 1) * TOK, (bf16*)(ws + WS_HID)};
            pg8::gemm_phase<pg8::EpiMlpIn, pg8::StaticOrder, PG8_ALIGN, PG8_SP2>(F.lds, g, S, E);
        }
#endif
        SEAM(pb + 5);
#ifndef NO_G4
        if (IN(pb + 6)) {
            FRESH(); float* ssq = (float*)(ws + WS_SSQ);
            pg8::Gemm g{(const bf16*)(ws + WS_HID), (const bf16*)(ws + WS_W + (size_t)l * WL_STRIDE + WO_2), TOK, DMODEL, DFF}; pg8::StaticOrder S; S.init(TOK, DMODEL, F.G, (int)blockIdx.x);
            pg8::EpiResid E{P->out, P->out, l == 0 ? (bf16*)(ws + WS_XB) : (bf16*)nullptr, l == 0 ? ssq + (size_t)2 * TOK : (float*)nullptr};
            pg8::gemm_phase<pg8::EpiResid, pg8::StaticOrder, PG8_ALIGN, PG8_SP2>(F.lds, g, S, E);
        }
#endif
        SEAM(pb + 6);
    }
#undef IN
#undef SEAM
#undef FRESH
}

extern "C" void kernel_launch(void* const* d_in, const int* in_sizes, int n_in, void* d_out, int out_size, void* d_ws, size_t ws_size, hipStream_t stream) {
    static int grid = 0;
    if (grid == 0) {
        if (n_in != 16 || in_sizes[0] != TOK * DMODEL || out_size != TOK * DMODEL || ws_size < WS_END) {
            fprintf(stderr, "kernel_launch: unexpected shapes / workspace (n_in %d, in0 %d, out %d, ws %zu, need %zu); nothing launched\n", n_in, n_in > 0 ? in_sizes[0] : -1, out_size, ws_size, (size_t)WS_END); grid = -1; return; }
        int dev = 0, cus = 0, per_cu = 0;
        if (hipGetDevice(&dev) != hipSuccess || hipDeviceGetAttribute(&cus, hipDeviceAttributeMultiprocessorCount, dev) != hipSuccess) { grid = -1; return; }
        if (hipFuncSetAttribute((const void*)fwd_kernel, hipFuncAttributeMaxDynamicSharedMemorySize, LDS_BYTES) != hipSuccess) { fprintf(stderr, "kernel_launch: hipFuncSetAttribute failed\n"); grid = -1; return; }
        if (hipOccupancyMaxActiveBlocksPerMultiprocessor(&per_cu, (const void*)fwd_kernel, NWAVES * 64, LDS_BYTES) != hipSuccess || per_cu < 1) { fprintf(stderr, "kernel_launch: occupancy query says %d blocks per CU\n", per_cu); per_cu = 1; }
        (void)hipGetLastError();
        grid = cus * per_cu;
    }
    if (grid < 0) return;
    if (hipMemsetAsync((char*)d_ws + WS_BAR, 0, BAR_ZERO_BYTES, stream) != hipSuccess) { fprintf(stderr, "kernel_launch: memset of the barrier words failed\n"); return; }
    Params p{};
    const float** pp = (const float**)&p;
    for (int i = 0; i < 16; ++i) pp[i] = (const float*)d_in[i];
    p.out = (float*)d_out; p.ws = (unsigned char*)d_ws;
#if MK_SPLIT
    for (int ph = 0; ph < NPHASE; ++ph) { p.ph_lo = ph; p.ph_hi = ph + 1; hipLaunchKernelGGL(fwd_kernel, dim3(grid), dim3(NWAVES * 64), LDS_BYTES, stream, p); }
#else
#ifndef MK_PH_HI
#define MK_PH_HI NPHASE
#endif
    p.ph_lo = 0; p.ph_hi = MK_PH_HI;
    void* args[] = {&p};
    const hipError_t e = hipLaunchCooperativeKernel((const void*)fwd_kernel, dim3(grid), dim3(NWAVES * 64), args, LDS_BYTES, stream);
    if (e != hipSuccess) fprintf(stderr, "kernel_launch: cooperative launch failed: %s (grid %d)\n", hipGetErrorString(e), grid);
#endif
}
```
